# Optimizing an MI355X kernel written in HIP

```python
import jax, jax.numpy as jnp
from jax import lax
import numpy as np

D_MODEL = 1024
BATCH = 8
SEQ = 4096
DEPTH = 4

CHUNK = 64
N_META = 16
CONV_WIDTH = 3
D_CONV = D_MODEL
N_RET_HEADS = 4
RET_QK_DIM = 256
RET_V_DIM = 512
D_RET_QK = N_RET_HEADS * RET_QK_DIM
D_RET_V = N_RET_HEADS * RET_V_DIM
ROPE_BASE = 10000.0
RMS_EPS = 1e-6
GN_EPS = 1e-5
D_IN = 4 * D_CONV + 2 * D_RET_QK + 2 * D_RET_V + 2 * D_MODEL

kernel_name = "hybrid_shortconv_retention_metatoken_trunk"


def _rmsnorm(x, g):
    xf = x.astype(jnp.float32)
    y = xf * lax.rsqrt(jnp.mean(xf * xf, axis=-1, keepdims=True) + RMS_EPS)
    return (y * g.astype(jnp.float32)).astype(x.dtype)


def _rope(x, pos):
    half = x.shape[-1] // 2
    inv = ROPE_BASE ** (-jnp.arange(half, dtype=jnp.float32) / half)
    ang = pos[:, None] * inv[None, :]
    cos = jnp.cos(ang)[None, :, None, :]
    sin = jnp.sin(ang)[None, :, None, :]
    x1, x2 = x[..., :half], x[..., half:]
    return jnp.concatenate([x1 * cos - x2 * sin, x1 * sin + x2 * cos], axis=-1)


def _short_conv_branch(h, gb, gc, z, conv_w, conv_b, w_out):
    u = gc * h
    up = jnp.pad(u, ((0, 0), (CONV_WIDTH - 1, 0), (0, 0)))
    T = u.shape[1]
    y = conv_b + sum(conv_w[j] * up[:, j:j + T] for j in range(CONV_WIDTH))
    y = gb * y * jax.nn.silu(z)
    return y @ w_out


def _retention_branch(q, k, v, z, gn_g, w_out):
    Bsz, T, _ = q.shape
    H, dk, dv = N_RET_HEADS, RET_QK_DIM, RET_V_DIM
    pos = jnp.arange(T, dtype=jnp.float32)
    qf = _rope(q.astype(jnp.float32).reshape(Bsz, T, H, dk), pos)
    kf = _rope(k.astype(jnp.float32).reshape(Bsz, T, H, dk), pos) * (dk ** -0.5)
    vf = v.astype(jnp.float32).reshape(Bsz, T, H, dv)
    n_pad = (-N_META) % CHUNK
    padw = ((0, 0), (n_pad, 0), (0, 0), (0, 0))
    qf, kf, vf = (jnp.pad(a, padw) for a in (qf, kf, vf))
    L = T + n_pad
    n_chunks = L // CHUNK

    def to_chunks(a):
        return a.reshape(Bsz, n_chunks, CHUNK, H, a.shape[-1]).transpose(1, 0, 3, 2, 4)

    qc, kc, vc = to_chunks(qf), to_chunks(kf), to_chunks(vf)
    log_g = jnp.log(1.0 - 2.0 ** (-5.0 - jnp.arange(H, dtype=jnp.float32)))
    idx = jnp.arange(CHUNK, dtype=jnp.float32)
    intra_dec = jnp.exp(log_g[:, None, None] * jnp.abs(idx[:, None] - idx[None, :]))
    q_dec = jnp.exp(log_g[:, None] * (idx + 1.0))[None, :, :, None]
    k_dec = jnp.exp(log_g[:, None] * (CHUNK - 1.0 - idx))[None, :, :, None]
    chunk_dec = jnp.exp(log_g * CHUNK)[None, :, None, None]

    def step(state, inp):
        qi, ki, vi = inp
        s = jnp.einsum('bhnd,bhmd->bhnm', qi, ki) * intra_dec
        intra = jnp.einsum('bhnm,bhmv->bhnv', s, vi)
        cross = jnp.einsum('bhnd,bhdv->bhnv', qi * q_dec, state)
        new_state = state * chunk_dec + jnp.einsum('bhmd,bhmv->bhdv', ki * k_dec, vi)
        return new_state, intra + cross

    state0 = jnp.zeros((Bsz, H, dk, dv), jnp.float32)
    _, out = lax.scan(step, state0, (qc, kc, vc))
    out = out.transpose(1, 0, 3, 2, 4).reshape(Bsz, L, H, dv)[:, n_pad:]
    mu = jnp.mean(out, axis=-1, keepdims=True)
    var = jnp.mean(jnp.square(out - mu), axis=-1, keepdims=True)
    out = (out - mu) * lax.rsqrt(var + GN_EPS) * gn_g.astype(jnp.float32).reshape(H, dv)
    out = out.reshape(Bsz, T, D_RET_V).astype(z.dtype) * jax.nn.silu(z)
    return out @ w_out


def setup_inputs(seed: int = 0) -> dict:
    key = jax.random.key(seed)
    ks = jax.random.split(key, 16)
    nrm = jax.random.normal
    f32 = jnp.float32
    return {
        "x": nrm(ks[0], (BATCH, SEQ, D_MODEL), f32),
        "meta": nrm(ks[1], (N_META, D_MODEL), f32),
        "pre_norm_g": 1.0 + 0.05 * nrm(ks[2], (DEPTH, D_MODEL), f32),
        "w_in": nrm(ks[3], (DEPTH, D_MODEL, D_IN), f32) * D_MODEL ** -0.5,
        "b_in": 0.02 * nrm(ks[4], (DEPTH, D_IN), f32),
        "conv_w": nrm(ks[5], (DEPTH, CONV_WIDTH, D_CONV), f32) * CONV_WIDTH ** -0.5,
        "conv_b": 0.02 * nrm(ks[6], (DEPTH, D_CONV), f32),
        "w_conv_out": nrm(ks[7], (DEPTH, D_CONV, D_MODEL), f32) * D_CONV ** -0.5,
        "ret_gn_g": 1.0 + 0.05 * nrm(ks[8], (DEPTH, D_RET_V), f32),
        "w_ret_out": nrm(ks[9], (DEPTH, D_RET_V, D_MODEL), f32) * D_RET_V ** -0.5,
        "w_o": nrm(ks[10], (DEPTH, D_MODEL, D_MODEL), f32) * D_MODEL ** -0.5,
        "post_norm_g": 1.0 + 0.05 * nrm(ks[11], (DEPTH, D_MODEL), f32),
    }


def reference(x, meta, pre_norm_g, w_in, b_in, conv_w, conv_b, w_conv_out,
              ret_gn_g, w_ret_out, w_o, post_norm_g):
    Bsz = x.shape[0]
    meta_b = jnp.broadcast_to(meta[None].astype(x.dtype), (Bsz, N_META, D_MODEL))
    h = jnp.concatenate([meta_b, x], axis=1)
    sizes = (D_CONV,) * 4 + (D_RET_QK,) * 2 + (D_RET_V,) * 2 + (D_MODEL,) * 2
    split_at = [int(s) for s in np.cumsum(sizes)[:-1]]
    for l in range(DEPTH):
        xn = _rmsnorm(h, pre_norm_g[l])
        proj = xn @ w_in[l] + b_in[l]
        c_h, c_b, c_c, c_z, r_q, r_k, r_v, r_z, g_a, g_b = jnp.split(proj, split_at, axis=-1)
        y_a = _short_conv_branch(c_h, c_b, c_c, c_z, conv_w[l], conv_b[l], w_conv_out[l])
        y_b = _retention_branch(r_q, r_k, r_v, r_z, ret_gn_g[l], w_ret_out[l])
        y = jax.nn.sigmoid(g_a) * y_a + jax.nn.sigmoid(g_b) * y_b
        y = y @ w_o[l]
        h = h + _rmsnorm(y, post_norm_g[l])
    return h[:, N_META:]
```

```cpp
#include <hip/hip_runtime.h>
#include <hip/hip_cooperative_groups.h>
#include <cstdio>
namespace cg = cooperative_groups;
namespace pg8 {
#define PG8_LAS __attribute__((address_space(3)))
typedef unsigned short bf16_t;
typedef short bf16x8 __attribute__((ext_vector_type(8)));
typedef float f32x4 __attribute__((ext_vector_type(4)));
typedef unsigned u32x4 __attribute__((ext_vector_type(4)));
constexpr int BM = 256, BK = 64, HALF = 128, HTB = HALF * BK * 2  , STAGE_BYTES = 8 * HTB, NXCD = 8, WGM = 8;

__host__ __device__ __forceinline__ int lds_byte(int r, int c) { const int st = (r >> 4) * 2 + (c >> 5), rr = r & 15, cc = c & 31, ob = rr * 64 + cc * 2; return st * 1024 + (ob ^ (((ob >> 9) & 1) << 5)); }
__host__ __device__ __forceinline__ void stage_rc(int b, int& R, int& C) { const int st = b / 1024, sb = b % 1024, swz = sb ^ (((sb >> 9) & 1) << 5); R = (st >> 1) * 16 + swz / 64; C = (st & 1) * 32 + (swz % 64) / 2; }
__host__ __device__ __forceinline__ int perm32(int rho) { const int n = rho >> 4, i = rho & 15; return 8 * (i >> 2) + 4 * n + (i & 3); }

struct Unit { int pm, pn; };
struct Gemm { const bf16_t* A; const bf16_t* Bt; int M, N, K; };

struct StaticOrder {
    int nM, nN, nwg, G, c;
    __host__ __device__ void init(int M, int N, int G_, int c_) { nM = M / BM; nN = N / BM; nwg = nM * nN; G = G_; c = c_; }
    __host__ __device__ bool next(int i, Unit& u) const {
        const long L = (long)i * G + c; if (L >= nwg) return false;
        int wgid = (int)L; { const int q = nwg / NXCD, r = nwg % NXCD, xcd = wgid % NXCD, off = wgid / NXCD; wgid = (xcd < r ? xcd * (q + 1) : r * (q + 1) + (xcd - r) * q) + off; }
        const int nig = WGM * nN, gid = wgid / nig, fm = gid * WGM, gsz = (nM - fm) < WGM ? (nM - fm) : WGM;
        u.pm = fm + ((wgid % nig) % gsz); u.pn = (wgid % nig) / gsz; return true;
    }
    __device__ __forceinline__ void a_ready(const Unit&) const {}
    __device__ __forceinline__ void done(const Unit&) const {}
};
struct CountedOrder : StaticOrder {
    const unsigned* ready; unsigned need; unsigned* tmo;
    __device__ __forceinline__ void a_ready(const Unit& u) const {
        if (threadIdx.x < 64) {
            const unsigned long long t0 = __builtin_amdgcn_s_memrealtime(); unsigned polls = 0;
            while ((unsigned)__builtin_amdgcn_readfirstlane(__hip_atomic_load(ready + 64 * u.pm, __ATOMIC_RELAXED, __HIP_MEMORY_SCOPE_AGENT)) < need) {
                if ((++polls & 255u) == 0u && __builtin_amdgcn_readfirstlane(__hip_atomic_load(tmo, __ATOMIC_RELAXED, __HIP_MEMORY_SCOPE_AGENT)) != 0u) break;
                if (__builtin_amdgcn_s_memrealtime() - t0 > 2000000ull) {
                    if (threadIdx.x == 0) { unsigned expect = 0u; __hip_atomic_compare_exchange_strong(tmo + 1, &expect, 0x600u | (unsigned)(u.pm & 0xff), __ATOMIC_RELAXED, __ATOMIC_RELAXED, __HIP_MEMORY_SCOPE_AGENT); __hip_atomic_store(tmo, 1u, __ATOMIC_RELAXED, __HIP_MEMORY_SCOPE_AGENT); }
                    break; }
                __builtin_amdgcn_s_sleep(2); }
            __builtin_amdgcn_fence(__ATOMIC_ACQUIRE, "agent");
            asm volatile("s_waitcnt vmcnt(0)" ::: "memory");
        }
#if !defined(BROKEN_HOOK_NO_BARRIER)
        asm volatile("" ::: "memory"); __builtin_amdgcn_s_barrier(); asm volatile("" ::: "memory");
#endif
    }
};

__device__ __forceinline__ unsigned cvt_pk_bf16(float lo, float hi) { unsigned r; asm volatile("v_cvt_pk_bf16_f32 %0, %1, %2" : "=v"(r) : "v"(lo), "v"(hi)); return r; }
typedef float f32x2 __attribute__((ext_vector_type(2)));
__device__ __forceinline__ f32x2 gelu_pk(f32x2 v) {
    const f32x2 av = __builtin_elementwise_abs(v), d = av * 0.2316418882f + 1.0f;
    f32x2 t; t.x = __builtin_amdgcn_rcpf(d.x); t.y = __builtin_amdgcn_rcpf(d.y);
    f32x2 q = t * 0.5307027145f + (-0.7265760135f); q = q * t + 0.7107068705f; q = q * t + (-0.142248368f); q = q * t + 0.127414796f; q = q * t;
    const f32x2 s = (v * v) * (-0.72134752044f);
    f32x2 e; e.x = __builtin_amdgcn_exp2f(s.x); e.y = __builtin_amdgcn_exp2f(s.y);
    const f32x2 m = v * (q * e), r = v - m;
    f32x2 o; o.x = v.x < 0.f ? m.x : r.x; o.y = v.y < 0.f ? m.y : r.y; return o;
}

template <class Epi, class Sched, bool STAMP = false>
__device__ __forceinline__ void gemm_phase(PG8_LAS unsigned char* lds, const Gemm g, const Sched& S, const Epi& E, unsigned long long* stamps) {
    int tid_l = threadIdx.x; asm volatile("" : "+v"(tid_l));
    const int tid = tid_l, wid = __builtin_amdgcn_readfirstlane(tid >> 6), lane = tid & 63, wr = wid >> 2, wc = wid & 3, fr = lane & 15, fq = lane >> 4;
    const int K = g.K, nt = K / BK;
    int ts_lo = 0, ts_hi = 0, nts = 0; const unsigned long long rt_entry = STAMP ? (unsigned long long)wall_clock64() : 0ull;
#define PG8_STAMP() do { if (STAMP && wid == 0 && nts < 64) { const unsigned long long _c = (unsigned long long)clock64(); \
        ts_lo = (lane == nts) ? (int)(unsigned)_c : ts_lo; ts_hi = (lane == nts) ? (int)(unsigned)(_c >> 32) : ts_hi; ++nts; } } while (0)
    PG8_STAMP();
    unsigned voffA[2], voffB[2];
#pragma unroll
    for (int i = 0; i < 2; ++i) { int R, C; stage_rc(tid * 16 + i * 8192, R, C); const int Rb = Epi::PERM ? ((R & ~31) + perm32(R & 31)) : R;
        voffA[i] = (unsigned)(R * K + C) * 2u; voffB[i] = (unsigned)(Rb * K + C) * 2u; }
    const size_t kstep = (size_t)(BK * 2);
    const size_t hstep = (size_t)HALF * K * 2;
    const size_t tstep = 2 * hstep;
    const unsigned ldsw = (unsigned)wid * 1024u;
    const int aoff = lds_byte(wr * 64 + fr, fq * 8), boff = lds_byte(wc * 32 + fr, fq * 8);
#define PG8_SA(b, h) (((b) * 2 + (h)) * HTB)
#define PG8_SB(b, h) ((4 + (b) * 2 + (h)) * HTB)
#define PG8_STAGE(bufoff, gbase, voff) do { _Pragma("unroll") for (int _i = 0; _i < 2; ++_i) \
        __builtin_amdgcn_global_load_lds((const unsigned*)((const char*)(gbase) + (voff)[_i]), (PG8_LAS unsigned*)(lds + (bufoff) + ldsw + _i * 8192), 16, 0, 0); } while (0)
#define PG8_LDA(dst, b, h) do { _Pragma("unroll") for (int m = 0; m < 4; ++m) _Pragma("unroll") for (int k = 0; k < 2; ++k) dst[m][k] = *(const PG8_LAS bf16x8*)(lds + PG8_SA(b, h) + aoff + m * 2048 + k * 1024); } while (0)
#define PG8_LDB(dst, b, h) do { _Pragma("unroll") for (int n = 0; n < 2; ++n) _Pragma("unroll") for (int k = 0; k < 2; ++k) dst[n][k] = *(const PG8_LAS bf16x8*)(lds + PG8_SB(b, h) + boff + n * 2048 + k * 1024); } while (0)
#define PG8_MMA(ai, bj, At, Bt) do { __builtin_amdgcn_s_setprio(1); _Pragma("unroll") for (int m = 0; m < 4; ++m) _Pragma("unroll") for (int n = 0; n < 2; ++n) _Pragma("unroll") for (int k = 0; k < 2; ++k) \
        acc[ai][bj][m][n] = __builtin_amdgcn_mfma_f32_16x16x32_bf16(Bt[n][k], At[m][k], acc[ai][bj][m][n], 0, 0, 0); __builtin_amdgcn_s_setprio(0); } while (0)
#define PG8_WAIT_V(n) asm volatile("s_waitcnt vmcnt(" #n ")" ::: "memory")
#define PG8_WAIT_L(n) asm volatile("s_waitcnt lgkmcnt(" #n ")" ::: "memory")
#define PG8_BAR __builtin_amdgcn_s_barrier()
#define PG8_SCHED __builtin_amdgcn_sched_barrier(0)
    Unit cur, nxt; int ui = 0;
    if (!S.next(0, cur)) return;
    f32x4 acc[2][2][4][2];
#pragma unroll
    for (int a = 0; a < 2; ++a)
#pragma unroll
        for (int b = 0; b < 2; ++b)
#pragma unroll
            for (int m = 0; m < 4; ++m)
#pragma unroll
                for (int n = 0; n < 2; ++n) acc[a][b][m][n] = (f32x4){0.f, 0.f, 0.f, 0.f};
    bf16x8 At[4][2], B0[2][2], B1[2][2];
    const char* cA = (const char*)g.A + (size_t)cur.pm * tstep; const char* cB = (const char*)g.Bt + (size_t)cur.pn * tstep;
    S.a_ready(cur);
    PG8_STAGE(PG8_SB(0, 0), cB, voffB); PG8_STAGE(PG8_SA(0, 0), cA, voffA); PG8_STAGE(PG8_SB(0, 1), cB + hstep, voffB); PG8_STAGE(PG8_SA(0, 1), cA + hstep, voffA);
    if (wr == 1) PG8_BAR;
    PG8_WAIT_V(4); PG8_BAR;
    PG8_STAGE(PG8_SB(1, 0), cB + kstep, voffB); PG8_STAGE(PG8_SA(1, 0), cA + kstep, voffA); PG8_STAGE(PG8_SB(1, 1), cB + hstep + kstep, voffB);
    PG8_WAIT_V(6); PG8_BAR;
    PG8_STAMP();
    for (;;) {
        const bool has_next = S.next(ui + 1, nxt);
        const char* nA = has_next ? (const char*)g.A + (size_t)nxt.pm * tstep : cA; const char* nB = has_next ? (const char*)g.Bt + (size_t)nxt.pn * tstep : cB;
        for (int t = 0; t < nt; t += 2) {
            const bool last = (t == nt - 2);
            const char* a1 = cA + (size_t)(t + 1) * kstep;
            const char* a2 = last ? nA : cA + (size_t)(t + 2) * kstep; const char* b2 = last ? nB : cB + (size_t)(t + 2) * kstep;
            const char* a3 = a2 + kstep; const char* b3 = b2 + kstep;
            if (last && has_next) S.a_ready(nxt);
            PG8_LDB(B0, 0, 0); PG8_SCHED; PG8_LDA(At, 0, 0); PG8_STAGE(PG8_SA(1, 1), a1 + hstep, voffA);
            PG8_WAIT_L(8); PG8_BAR; PG8_WAIT_L(0); PG8_MMA(0, 0, At, B0); PG8_BAR; PG8_SCHED;
            PG8_LDB(B1, 0, 1); PG8_STAGE(PG8_SB(0, 0), b2, voffB);
            PG8_BAR; PG8_WAIT_L(0); PG8_MMA(0, 1, At, B1); PG8_BAR;
            PG8_LDA(At, 0, 1); PG8_STAGE(PG8_SA(0, 0), a2, voffA);
            PG8_BAR; PG8_WAIT_L(0); PG8_MMA(1, 0, At, B0); PG8_BAR; PG8_SCHED;
            PG8_STAGE(PG8_SB(0, 1), b2 + hstep, voffB);
            PG8_WAIT_V(6); PG8_BAR; PG8_MMA(1, 1, At, B1); PG8_BAR;
            PG8_LDB(B0, 1, 0); PG8_SCHED; PG8_LDA(At, 1, 0); PG8_STAGE(PG8_SA(0, 1), a2 + hstep, voffA);
            PG8_WAIT_L(8); PG8_BAR; PG8_WAIT_L(0); PG8_MMA(0, 0, At, B0); PG8_BAR; PG8_SCHED;
            PG8_LDB(B1, 1, 1); PG8_STAGE(PG8_SB(1, 0), b3, voffB);
            PG8_BAR; PG8_WAIT_L(0); PG8_MMA(0, 1, At, B1); PG8_BAR;
            PG8_LDA(At, 1, 1); PG8_STAGE(PG8_SA(1, 0), a3, voffA);
            PG8_BAR; PG8_WAIT_L(0); PG8_MMA(1, 0, At, B0); PG8_BAR; PG8_SCHED;
            PG8_STAGE(PG8_SB(1, 1), b3 + hstep, voffB);
            PG8_WAIT_V(6); PG8_BAR; PG8_MMA(1, 1, At, B1); PG8_BAR;
        }
        PG8_STAMP();
        if constexpr (!Epi::AFTER_DRAIN) { E(acc, cur, wr, wc, fr, fq); S.done(cur); }
        PG8_STAMP();
        if (!has_next) break;
#pragma unroll
        for (int a = 0; a < 2; ++a)
#pragma unroll
            for (int b = 0; b < 2; ++b)
#pragma unroll
                for (int m = 0; m < 4; ++m)
#pragma unroll
                    for (int n = 0; n < 2; ++n) acc[a][b][m][n] = (f32x4){0.f, 0.f, 0.f, 0.f};
        cur = nxt; cA = nA; cB = nB; ++ui;
    }
    PG8_WAIT_V(0);
    if (wr == 0) PG8_BAR;
    PG8_BAR;
    if constexpr (Epi::AFTER_DRAIN) { E.fused(acc, cur, wr, wc, fr, fq, lds, wid, lane); S.done(cur); }
    PG8_STAMP();
    if (STAMP && wid == 0) { stamps[lane] = lane < nts ? (((unsigned long long)(unsigned)ts_hi << 32) | (unsigned)ts_lo) : 0ull;
        if (lane == 62) stamps[62] = rt_entry; if (lane == 63) stamps[63] = (unsigned long long)wall_clock64(); }
#undef PG8_STAMP
#undef PG8_SA
#undef PG8_SB
#undef PG8_STAGE
#undef PG8_LDA
#undef PG8_LDB
#undef PG8_MMA
#undef PG8_WAIT_V
#undef PG8_WAIT_L
#undef PG8_BAR
#undef PG8_SCHED
}
}
__device__ const double INV_REV[128] = {0.15915494309189535,0.14810514021707516,0.13782250260398285,0.1282537675342271,0.11934937021124886,0.11106318702115607,0.10335229661843406,0.096176757598987819,0.089499401608891013,0.083285640817172504,0.077503288755374058,0.072122393595852222,0.067115083005227255,0.062455419769340485,0.058119267441876246,0.054084165320725783,0.050329212104487035,0.04683495762645621,0.04358330210530733,0.040557402390591489,0.037741584717419771,0.035121263518410453,0.032682865872356998,0.030413761198270856,0.028302195830623399,0.02633723213689523,0.024508691862069852,0.022807103406603451,0.02122365276477766,0.019750137869302395,0.018378926105679667,0.01710291477625845,0.015915494309189534,0.014810514021707515,0.013782250260398284,0.012825376753422709,0.011934937021124886,0.011106318702115607,0.010335229661843406,0.0096176757598987819,0.0089499401608891024,0.0083285640817172511,0.0077503288755374055,0.0072122393595852232,0.0067115083005227253,0.0062455419769340478,0.0058119267441876241,0.0054084165320725779,0.0050329212104487037,0.0046834957626456213,0.0043583302105307331,0.0040557402390591487,0.0037741584717419772,0.0035121263518410454,0.0032682865872356993,0.0030413761198270859,0.0028302195830623399,0.0026337232136895228,0.0024508691862069852,0.0022807103406603446,0.0021223652764777662,0.0019750137869302396,0.0018378926105679667,0.0017102914776258452,0.0015915494309189536,0.0014810514021707515,0.0013782250260398288,0.0012825376753422709,0.0011934937021124885,0.0011106318702115607,0.0010335229661843405,0.00096176757598987806,0.00089499401608891024,0.00083285640817172503,0.00077503288755374051,0.00072122393595852228,0.0006711508300522726,0.00062455419769340487,0.00058119267441876239,0.00054084165320725773,0.00050329212104487033,0.00046834957626456218,0.00043583302105307329,0.00040557402390591486,0.00037741584717419774,0.00035121263518410453,0.00032682865872356992,0.0003041376119827086,0.00028302195830623395,0.00026337232136895234,0.00024508691862069854,0.00022807103406603446,0.00021223652764777661,0.00019750137869302395,0.00018378926105679666,0.00017102914776258454,0.00015915494309189535,0.00014810514021707514,0.00013782250260398286,0.00012825376753422709,0.00011934937021124886,0.00011106318702115607,0.00010335229661843406,9.6176757598987812e-05,8.9499401608891018e-05,8.3285640817172505e-05,7.7503288755374056e-05,7.2122393595852225e-05,6.7115083005227254e-05,6.2455419769340487e-05,5.8119267441876239e-05,5.4084165320725784e-05,5.0329212104487035e-05,4.6834957626456207e-05,4.3583302105307322e-05,4.0557402390591481e-05,3.7741584717419777e-05,3.5121263518410453e-05,3.2682865872356999e-05,3.0413761198270857e-05,2.8302195830623396e-05,2.6337232136895232e-05,2.4508691862069852e-05,2.2807103406603447e-05,2.1223652764777659e-05,1.9750137869302396e-05,1.8378926105679668e-05,1.7102914776258452e-05};

using pg8::bf16_t; using pg8::bf16x8; using pg8::f32x4; using pg8::u32x4; using pg8::Unit;
#define LAS __attribute__((address_space(3)))
typedef float f32x16 __attribute__((ext_vector_type(16)));
typedef short s16x4 __attribute__((ext_vector_type(4)));
typedef unsigned u32x2 __attribute__((ext_vector_type(2)));
typedef float f32x2 __attribute__((ext_vector_type(2)));

constexpr int DM = 1024, NB = 8, SEQ = 4096, LP = 4160, NPAD = 48, NROW = NB * LP;
constexpr int DIN = 12288, DEPTH = 4, NA = 10240, NG = 2048, NCH = 65;
constexpr int LDS_BYTES = 131072;
constexpr size_t SZ1 = (size_t)NROW * 1024 * 2;
constexpr size_t WS_XN = 0, WS_U = SZ1, WS_MG = 2 * SZ1, WS_Q = 3 * SZ1, WS_K = 4 * SZ1, WS_VH = 5 * SZ1, WS_SZ = 7 * SZ1;
constexpr size_t WS_WIN = 9 * SZ1, WS_WCO = WS_WIN + (size_t)DIN * 1024 * 2, WS_WRO = WS_WCO + 1024 * 1024 * 2, WS_WO = WS_WRO + 1024 * 2048 * 2;
constexpr size_t WS_BP = WS_WO + 1024 * 1024 * 2, WS_ROPE = WS_BP + DIN * 4, WS_STAT = WS_ROPE + 2 * (size_t)4112 * 128 * 4;
constexpr size_t WS_HMETA = WS_STAT + (size_t)NROW * 4 * 16 * 8, WS_END = WS_HMETA + 8 * 16 * 1024 * 4;

struct Params { const float* x; const float* meta; const float* pre_g; const float* w_in; const float* b_in; const float* conv_w; const float* conv_b;
                const float* w_co; const float* gn_g; const float* w_ro; const float* w_o; const float* post_g; float* out; unsigned char* ws; };

__device__ __forceinline__ float bflo(unsigned u) { return __uint_as_float(u << 16); }
__device__ __forceinline__ float bfhi(unsigned u) { return __uint_as_float(u & 0xffff0000u); }
__device__ __forceinline__ unsigned pk(float lo, float hi) { return pg8::cvt_pk_bf16(lo, hi); }
__device__ __forceinline__ void unpack8(const u32x4 r, float (&f)[8]) { f[0] = bflo(r.x); f[1] = bfhi(r.x); f[2] = bflo(r.y); f[3] = bfhi(r.y); f[4] = bflo(r.z); f[5] = bfhi(r.z); f[6] = bflo(r.w); f[7] = bfhi(r.w); }
__device__ __forceinline__ u32x4 pack8(const float (&f)[8]) { u32x4 r; r.x = pk(f[0], f[1]); r.y = pk(f[2], f[3]); r.z = pk(f[4], f[5]); r.w = pk(f[6], f[7]); return r; }
__device__ __forceinline__ float silu_f(float y) { return y / (1.0f + __expf(-y)); }
__device__ __forceinline__ float sigm_f(float y) { return 1.0f / (1.0f + __expf(-y)); }
__device__ __forceinline__ float lg_gamma(int hd) { return hd == 0 ? -0.0458036896131f : hd == 1 ? -0.0227200765001f : hd == 2 ? -0.0113153132278f : -0.00564656314114f; }
__device__ __forceinline__ float wave_sum(float v) { for (int o = 32; o >= 1; o >>= 1) v += __shfl_xor(v, o); return v; }
#define LBAR() do { asm volatile("s_waitcnt lgkmcnt(0)" ::: "memory"); __builtin_amdgcn_s_barrier(); asm volatile("" ::: "memory"); } while (0)

struct EpiIn {
    static constexpr bool PERM = true, AFTER_DRAIN = false;
    bf16_t *U, *MG, *Q, *K, *VH, *SZ; const float* bperm; const float* ct; const float* st;
    __device__ __forceinline__ void operator()(const f32x4 (&acc)[2][2][4][2], const Unit& u, int wr, int wc, int fr, int fq) const {
        const int pn = u.pn, cc = wc * 32 + 8 * fq;
        f32x4 bv[2][2];
#pragma unroll
        for (int bj = 0; bj < 2; ++bj)
#pragma unroll
            for (int n = 0; n < 2; ++n) bv[bj][n] = *(const f32x4*)(bperm + pn * 256 + bj * 128 + cc + 4 * n);
#pragma unroll
        for (int ai = 0; ai < 2; ++ai)
#pragma unroll
            for (int m = 0; m < 4; ++m) {
                const int r = u.pm * 256 + ai * 128 + wr * 64 + m * 16 + fr; const int b = r / LP, p = r - b * LP;
                float x[8], y[8], o1[8], o2[8];
#pragma unroll
                for (int n = 0; n < 2; ++n)
#pragma unroll
                    for (int j = 0; j < 4; ++j) { x[4 * n + j] = acc[ai][0][m][n][j] + bv[0][n][j]; y[4 * n + j] = acc[ai][1][m][n][j] + bv[1][n][j]; }
                if (pn < 8) {
#pragma unroll
                    for (int e = 0; e < 8; ++e) o1[e] = x[e] * y[e];
                    *(u32x4*)(U + (size_t)r * 1024 + pn * 128 + cc) = pack8(o1);
                } else if (pn < 16) {
#pragma unroll
                    for (int e = 0; e < 8; ++e) o1[e] = x[e] * silu_f(y[e]);
                    *(u32x4*)(MG + (size_t)r * 1024 + (pn - 8) * 128 + cc) = pack8(o1);
                } else if (pn < 24) {
                    const bool isk = pn >= 20; const int hd = isk ? pn - 20 : pn - 16; const float sc = isk ? 0.0625f : 1.0f;
                    if (p >= NPAD) {
                        const float* cp = ct + (size_t)(p - NPAD) * 128 + cc; const float* sp = st + (size_t)(p - NPAD) * 128 + cc;
                        const f32x4 c0 = *(const f32x4*)cp, c1 = *(const f32x4*)(cp + 4), s0 = *(const f32x4*)sp, s1 = *(const f32x4*)(sp + 4);
#pragma unroll
                        for (int e = 0; e < 8; ++e) { const float c = e < 4 ? c0[e & 3] : c1[e & 3], s = e < 4 ? s0[e & 3] : s1[e & 3];
                            o1[e] = (x[e] * c - y[e] * s) * sc; o2[e] = (x[e] * s + y[e] * c) * sc; }
                    } else {
#pragma unroll
                        for (int e = 0; e < 8; ++e) { o1[e] = 0.f; o2[e] = 0.f; }
                    }
                    bf16_t* dst = (isk ? K : Q) + (size_t)r * 1024 + hd * 256 + cc;
                    *(u32x4*)dst = pack8(o1); *(u32x4*)(dst + 128) = pack8(o2);
                } else if (pn < 32) {
                    const int vt = pn - 24; const float dec = (p >= NPAD) ? exp2f(lg_gamma(vt >> 1) * (float)(63 - (p & 63))) : 0.f;
#pragma unroll
                    for (int e = 0; e < 8; ++e) { o1[e] = x[e] * dec; o2[e] = y[e] * dec; }
                    bf16_t* dst = VH + (size_t)r * 2048 + vt * 256 + cc;
                    *(u32x4*)dst = pack8(o1); *(u32x4*)(dst + 128) = pack8(o2);
                } else {
#pragma unroll
                    for (int e = 0; e < 8; ++e) { o1[e] = silu_f(x[e]); o2[e] = silu_f(y[e]); }
                    bf16_t* dst = SZ + (size_t)r * 2048 + (pn - 32) * 256 + cc;
                    *(u32x4*)dst = pack8(o1); *(u32x4*)(dst + 128) = pack8(o2);
                }
            }
    }
};
template <int MODE> struct EpiOut {
    static constexpr bool PERM = true, AFTER_DRAIN = false;
    const bf16_t* G; bf16_t* Y; bf16_t* Y2; const float* bias;
    __device__ __forceinline__ void operator()(const f32x4 (&acc)[2][2][4][2], const Unit& u, int wr, int wc, int fr, int fq) const {
        const int cc = wc * 32 + 8 * fq;
#pragma unroll
        for (int ai = 0; ai < 2; ++ai)
#pragma unroll
            for (int m = 0; m < 4; ++m) {
                const int r = u.pm * 256 + ai * 128 + wr * 64 + m * 16 + fr;
#pragma unroll
                for (int bj = 0; bj < 2; ++bj) {
                    float v[8], o[8];
#pragma unroll
                    for (int n = 0; n < 2; ++n)
#pragma unroll
                        for (int j = 0; j < 4; ++j) v[4 * n + j] = acc[ai][bj][m][n][j];
                    if (MODE == 0) {
                        const int c = u.pn * 256 + bj * 128 + cc;
                        const f32x4 b0 = *(const f32x4*)(bias + c), b1 = *(const f32x4*)(bias + c + 4);
#pragma unroll
                        for (int e = 0; e < 8; ++e) o[e] = sigm_f(v[e] + (e < 4 ? b0[e & 3] : b1[e & 3]));
                        bf16_t* dst = (u.pn < 4 ? Y : Y2) + (size_t)r * 1024 + (u.pn & 3) * 256 + bj * 128 + cc;
                        *(u32x4*)dst = pack8(o);
                    } else {
                        const size_t off = (size_t)r * 1024 + u.pn * 256 + bj * 128 + cc;
                        if (MODE == 3) {
#pragma unroll
                            for (int e = 0; e < 8; ++e) o[e] = v[e];
                        } else {
                            float g[8]; unpack8(*(const u32x4*)(G + off), g);
                            if (MODE == 1) {
#pragma unroll
                                for (int e = 0; e < 8; ++e) o[e] = g[e] * v[e];
                            } else {
                                float yv[8]; unpack8(*(const u32x4*)(Y + off), yv);
#pragma unroll
                                for (int e = 0; e < 8; ++e) o[e] = yv[e] + g[e] * v[e];
                            }
                        }
                        *(u32x4*)(Y + off) = pack8(o);
                    }
                }
            }
    }
};

__device__ __forceinline__ int dest_of_orig(int n) {
    if (n >= 4096) return n;
    const int grp = n >> 10, j = n & 1023, t = j >> 7, cc = j & 127;
    const int tile = (grp == 0 || grp == 2) ? t : 8 + t, half = (grp >= 2) ? 1 : 0;
    return tile * 256 + half * 128 + cc;
}
__device__ __forceinline__ void convert_phase(LAS unsigned char* lds, const Params& P, int l) {
    int tid_l = threadIdx.x; asm volatile("" : "+v"(tid_l));
    const int tid = tid_l; LAS float* T = (LAS float*)lds;
    unsigned char* ws = P.ws;
    for (int t = blockIdx.x; t < 4096; t += gridDim.x) {
        const float* src; bf16_t* dst; int K, N, kb, nb; bool perm = false;
        if (t < 3072) { src = P.w_in + (size_t)l * 1024 * DIN; dst = (bf16_t*)(ws + WS_WIN); K = 1024; N = DIN; kb = t / 192; nb = t % 192; perm = true; }
        else if (t < 3328) { const int q = t - 3072; src = P.w_co + (size_t)l * 1024 * 1024; dst = (bf16_t*)(ws + WS_WCO); K = 1024; N = 1024; kb = q >> 4; nb = q & 15; }
        else if (t < 3840) { const int q = t - 3328; src = P.w_ro + (size_t)l * 2048 * 1024; dst = (bf16_t*)(ws + WS_WRO); K = 2048; N = 1024; kb = q >> 4; nb = q & 15; }
        else { const int q = t - 3840; src = P.w_o + (size_t)l * 1024 * 1024; dst = (bf16_t*)(ws + WS_WO); K = 1024; N = 1024; kb = q >> 4; nb = q & 15; }
        const int k0 = tid >> 4, n4 = (tid & 15) * 4;
#pragma unroll
        for (int i = 0; i < 2; ++i) {
            const int k = k0 + 32 * i; const f32x4 v = *(const f32x4*)(src + (size_t)(kb * 64 + k) * N + nb * 64 + n4);
#pragma unroll
            for (int j = 0; j < 4; ++j) T[(n4 + j) * 65 + k] = v[j];
        }
        if (perm && kb == 0 && tid < 64) ((float*)(ws + WS_BP))[dest_of_orig(nb * 64 + tid)] = P.b_in[(size_t)l * DIN + nb * 64 + tid];
        __syncthreads();
        const int n = tid >> 3, kc = (tid & 7) * 8; float f[8];
#pragma unroll
        for (int j = 0; j < 8; ++j) f[j] = T[n * 65 + kc + j];
        const int drow = perm ? dest_of_orig(nb * 64 + n) : nb * 64 + n;
        *(u32x4*)(dst + (size_t)drow * K + kb * 64 + kc) = pack8(f);
        __syncthreads();
    }
    if (l == 0) {
        float* ct = (float*)(ws + WS_ROPE); float* st = ct + 4112 * 128;
        for (int idx = blockIdx.x * 512 + tid; idx < 4112 * 128; idx += gridDim.x * 512) {
            const int pos = idx >> 7, i = idx & 127; const double rev = (double)pos * INV_REV[i]; const float f = (float)(rev - floor(rev));
            ct[idx] = __builtin_amdgcn_cosf(f); st[idx] = __builtin_amdgcn_sinf(f);
        }
    }
}

__device__ __forceinline__ void norm_phase(const Params& P, int l) {
    int tid_l = threadIdx.x; asm volatile("" : "+v"(tid_l));
    const int tid = tid_l, lane = tid & 63, wv = tid >> 6;
    bf16_t* XN = (bf16_t*)(P.ws + WS_XN); float* HMETA = (float*)(P.ws + WS_HMETA);
    for (int row = blockIdx.x * 8 + wv; row < NROW; row += gridDim.x * 8) {
        const int b = row / LP, p = row - b * LP;
        bf16_t* xr = XN + (size_t)row * 1024;
        if (p < NPAD) {
            if (l < DEPTH) {
#pragma unroll
                for (int k = 0; k < 4; ++k) *(u32x2*)(xr + 256 * k + 4 * lane) = (u32x2){0u, 0u};
            }
            continue;
        }
        float* hp = p >= 64 ? P.out + (size_t)(b * SEQ + p - 64) * 1024 : HMETA + (size_t)(b * 16 + p - NPAD) * 1024;
        f32x4 v[4];
        if (l == 0) {
            const float* src = p >= 64 ? P.x + (size_t)(b * SEQ + p - 64) * 1024 : P.meta + (size_t)(p - NPAD) * 1024;
#pragma unroll
            for (int k = 0; k < 4; ++k) v[k] = *(const f32x4*)(src + 256 * k + 4 * lane);
        } else {
            f32x4 o[4]; float ss = 0.f;
#pragma unroll
            for (int k = 0; k < 4; ++k) { const u32x2 raw = *(const u32x2*)(xr + 256 * k + 4 * lane); o[k] = (f32x4){bflo(raw.x), bfhi(raw.x), bflo(raw.y), bfhi(raw.y)};
                ss += o[k][0] * o[k][0] + o[k][1] * o[k][1] + o[k][2] * o[k][2] + o[k][3] * o[k][3]; }
            ss = wave_sum(ss); const float rs = rsqrtf(ss * (1.0f / 1024.0f) + 1e-6f);
#pragma unroll
            for (int k = 0; k < 4; ++k) { const f32x4 g = *(const f32x4*)(P.post_g + (size_t)(l - 1) * 1024 + 256 * k + 4 * lane); const f32x4 hv = *(const f32x4*)(hp + 256 * k + 4 * lane);
                v[k] = hv + o[k] * rs * g; }
        }
#pragma unroll
        for (int k = 0; k < 4; ++k) *(f32x4*)(hp + 256 * k + 4 * lane) = v[k];
        if (l == DEPTH) continue;
        float s2 = 0.f;
#pragma unroll
        for (int k = 0; k < 4; ++k) s2 += v[k][0] * v[k][0] + v[k][1] * v[k][1] + v[k][2] * v[k][2] + v[k][3] * v[k][3];
        s2 = wave_sum(s2); const float r2 = rsqrtf(s2 * (1.0f / 1024.0f) + 1e-6f);
#pragma unroll
        for (int k = 0; k < 4; ++k) { const f32x4 g = *(const f32x4*)(P.pre_g + (size_t)l * 1024 + 256 * k + 4 * lane); const f32x4 y = v[k] * r2 * g;
            *(u32x2*)(xr + 256 * k + 4 * lane) = (u32x2){pk(y[0], y[1]), pk(y[2], y[3])}; }
    }
}

__device__ __forceinline__ bf16x8 tr2(LAS unsigned char* a0, LAS unsigned char* a1) {
    const s16x4 t0 = __builtin_amdgcn_ds_read_tr16_b64_v4i16((LAS s16x4*)a0), t1 = __builtin_amdgcn_ds_read_tr16_b64_v4i16((LAS s16x4*)a1);
    return __builtin_shufflevector(t0, t1, 0, 1, 2, 3, 4, 5, 6, 7);
}
__device__ __forceinline__ void scan_phase(LAS unsigned char* lds, const Params& P) {
    constexpr int QP = 528, VP = 144, OFF_Q = 0, OFF_K = 64 * QP, OFF_SB = 2 * 64 * QP, OFF_V = 3 * 64 * QP, OFF_P = OFF_V + 64 * VP;
    static_assert(OFF_P + 64 * VP <= LDS_BYTES, "scan LDS");
    int tid_l = threadIdx.x; asm volatile("" : "+v"(tid_l));
    const int tid = tid_l, lane = tid & 63, w = __builtin_amdgcn_readfirstlane(tid >> 6);
    const int lr = lane & 15, g = lane >> 4, l31 = lane & 31, hh = lane >> 5, blk = (lane >> 4) & 1, q4 = (lane & 15) >> 2, p4 = lane & 3;
    const bf16_t* Q = (const bf16_t*)(P.ws + WS_Q); const bf16_t* K = (const bf16_t*)(P.ws + WS_K); bf16_t* VH = (bf16_t*)(P.ws + WS_VH);
    float2* STAT = (float2*)(P.ws + WS_STAT);
    const int mb = w >> 1, nb0 = 2 * (w & 1), rb = w >> 1, cb0 = 2 * (w & 1);
    for (int chain = blockIdx.x; chain < 256; chain += gridDim.x) {
        const int b = chain >> 5, hd = (chain >> 3) & 3, sl = chain & 7; const float lg = lg_gamma(hd);
        f32x16 S[2];
#pragma unroll
        for (int i = 0; i < 16; ++i) { S[0][i] = 0.f; S[1][i] = 0.f; }
        for (int i = tid; i < 64 * QP / 16; i += 512) *(LAS u32x4*)(lds + OFF_SB + 16 * i) = (u32x4){0u, 0u, 0u, 0u};
        const size_t rowbase = (size_t)b * LP;
        u32x4 qr[4], kr[4], vr;
#define SCAN_LOAD(ci_) do { const size_t r0_ = rowbase + (size_t)(ci_) * 64; _Pragma("unroll") for (int i = 0; i < 4; ++i) { const int id = tid + 512 * i, row = id >> 5, ch = id & 31; \
            qr[i] = *(const u32x4*)(Q + (r0_ + row) * 1024 + hd * 256 + ch * 8); kr[i] = *(const u32x4*)(K + (r0_ + row) * 1024 + hd * 256 + ch * 8); } \
            vr = *(const u32x4*)(VH + (r0_ + (tid >> 3)) * 2048 + hd * 512 + sl * 64 + (tid & 7) * 8); } while (0)
#define SCAN_STORE() do { _Pragma("unroll") for (int i = 0; i < 4; ++i) { const int id = tid + 512 * i, row = id >> 5, ch = id & 31; \
            *(LAS u32x4*)(lds + OFF_Q + row * QP + ch * 16) = qr[i]; *(LAS u32x4*)(lds + OFF_K + row * QP + ch * 16) = kr[i]; } \
            *(LAS u32x4*)(lds + OFF_V + (tid >> 3) * VP + (tid & 7) * 16) = vr; } while (0)
        SCAN_LOAD(0); SCAN_STORE(); LBAR();
        for (int ci = 0; ci < NCH; ++ci) {
            const size_t r0 = rowbase + (size_t)ci * 64;
            if (ci + 1 < NCH) SCAN_LOAD(ci + 1);
            {
                f32x4 accP[2] = {(f32x4){0.f, 0.f, 0.f, 0.f}, (f32x4){0.f, 0.f, 0.f, 0.f}};
#pragma unroll
                for (int ks = 0; ks < 8; ++ks) {
                    const bf16x8 a = *(const LAS bf16x8*)(lds + OFF_K + (16 * mb + lr) * QP + (32 * ks + 8 * g) * 2);
#pragma unroll
                    for (int t = 0; t < 2; ++t) { const bf16x8 bq = *(const LAS bf16x8*)(lds + OFF_Q + (16 * (nb0 + t) + lr) * QP + (32 * ks + 8 * g) * 2);
                        accP[t] = __builtin_amdgcn_mfma_f32_16x16x32_bf16(a, bq, accP[t], 0, 0, 0); }
                }
#pragma unroll
                for (int t = 0; t < 2; ++t) { const int n = 16 * (nb0 + t) + lr; float pv[4];
#pragma unroll
                    for (int rg = 0; rg < 4; ++rg) { const int m = 16 * mb + 4 * g + rg, d = m - n; pv[rg] = accP[t][rg] * exp2f(lg * (float)(-64 + (d > 0 ? 2 * d : 0))); }
                    *(LAS u32x2*)(lds + OFF_P + n * VP + (16 * mb + 4 * g) * 2) = (u32x2){pk(pv[0], pv[1]), pk(pv[2], pv[3])}; }
            }
            LBAR();
            {
                f32x4 accO[2] = {(f32x4){0.f, 0.f, 0.f, 0.f}, (f32x4){0.f, 0.f, 0.f, 0.f}};
#pragma unroll
                for (int ks = 0; ks < 8; ++ks) {
                    const bf16x8 a = *(const LAS bf16x8*)(lds + OFF_Q + (16 * rb + lr) * QP + (32 * ks + 8 * g) * 2);
#pragma unroll
                    for (int t = 0; t < 2; ++t) { const bf16x8 bs = *(const LAS bf16x8*)(lds + OFF_SB + (16 * (cb0 + t) + lr) * QP + (32 * ks + 8 * g) * 2);
                        accO[t] = __builtin_amdgcn_mfma_f32_16x16x32_bf16(a, bs, accO[t], 0, 0, 0); }
                }
#pragma unroll
                for (int ks = 0; ks < 2; ++ks) {
                    const bf16x8 a = *(const LAS bf16x8*)(lds + OFF_P + (16 * rb + lr) * VP + (32 * ks + 8 * g) * 2);
#pragma unroll
                    for (int t = 0; t < 2; ++t) { LAS unsigned char* base = lds + OFF_V + (32 * ks + 8 * g + q4) * VP + (16 * (cb0 + t) + 4 * p4) * 2;
                        const bf16x8 bvv = tr2(base, base + 4 * VP);
                        accO[t] = __builtin_amdgcn_mfma_f32_16x16x32_bf16(a, bvv, accO[t], 0, 0, 0); }
                }
#pragma unroll
                for (int rg = 0; rg < 4; ++rg) { const int n = 16 * rb + 4 * g + rg; const float sc = exp2f(lg * (float)(n + 1));
                    const float v0 = accO[0][rg] * sc, v1 = accO[1][rg] * sc;
                    bf16_t* dst = VH + (r0 + n) * 2048 + hd * 512 + sl * 64 + 16 * cb0 + lr;
                    dst[0] = (bf16_t)(pk(v0, 0.f) & 0xffffu); dst[16] = (bf16_t)(pk(v1, 0.f) & 0xffffu);
                    float s = v0 + v1, q = v0 * v0 + v1 * v1;
#pragma unroll
                    for (int o = 8; o >= 1; o >>= 1) { s += __shfl_xor(s, o); q += __shfl_xor(q, o); }
                    if (lr == 0) STAT[((r0 + n) * 4 + hd) * 16 + sl * 2 + (w & 1)] = make_float2(s, q); }
            }
            {
                const float cd = exp2f(lg * 64.0f);
                S[0] *= cd; S[1] *= cd;
#pragma unroll
                for (int ks = 0; ks < 4; ++ks) {
                    LAS unsigned char* ab = lds + OFF_K + (16 * ks + 8 * hh + q4) * QP + (32 * w + 16 * blk + 4 * p4) * 2;
                    const bf16x8 a = tr2(ab, ab + 4 * QP);
#pragma unroll
                    for (int tv = 0; tv < 2; ++tv) { LAS unsigned char* bb = lds + OFF_V + (16 * ks + 8 * hh + q4) * VP + (32 * tv + 16 * blk + 4 * p4) * 2;
                        const bf16x8 bvv = tr2(bb, bb + 4 * VP);
                        S[tv] = __builtin_amdgcn_mfma_f32_32x32x16_bf16(a, bvv, S[tv], 0, 0, 0); }
                }
            }
            LBAR();
#pragma unroll
            for (int tv = 0; tv < 2; ++tv)
#pragma unroll
                for (int rg = 0; rg < 4; ++rg)
                    *(LAS u32x2*)(lds + OFF_SB + (32 * tv + l31) * QP + (32 * w + 8 * rg + 4 * hh) * 2) = (u32x2){pk(S[tv][4 * rg], S[tv][4 * rg + 1]), pk(S[tv][4 * rg + 2], S[tv][4 * rg + 3])};
            if (ci + 1 < NCH) SCAN_STORE();
            LBAR();
        }
#undef SCAN_LOAD
#undef SCAN_STORE
    }
}

__device__ __forceinline__ void elem_phase(LAS unsigned char* lds, const Params& P, int l) {
    int tid_l = threadIdx.x; asm volatile("" : "+v"(tid_l));
    const int tid = tid_l, rl = tid >> 7, t = tid & 127;
    const bf16_t* U = (const bf16_t*)(P.ws + WS_U); bf16_t* MG = (bf16_t*)(P.ws + WS_MG); bf16_t* RET = (bf16_t*)(P.ws + WS_VH); const bf16_t* SZ = (const bf16_t*)(P.ws + WS_SZ);
    const float2* STAT = (const float2*)(P.ws + WS_STAT); LAS f32x2* ST = (LAS f32x2*)lds;
    const int c8 = t * 8;
    float w0[8], w1[8], w2[8], cb[8];
    { const float* cw = P.conv_w + (size_t)l * 3 * 1024 + c8; const float* cbp = P.conv_b + (size_t)l * 1024 + c8;
#pragma unroll
      for (int e = 0; e < 8; ++e) { w0[e] = cw[e]; w1[e] = cw[1024 + e]; w2[e] = cw[2048 + e]; cb[e] = cbp[e]; } }
    for (int it = blockIdx.x; it < NROW / 4; it += gridDim.x) {
        const int row = it * 4 + rl; const int b = row / LP, p = row - b * LP;
        __syncthreads();
        if (tid < 16) { const int row2 = it * 4 + (tid >> 2), hd = tid & 3; const float2* sp = STAT + ((size_t)row2 * 4 + hd) * 16; float s = 0.f, q = 0.f;
#pragma unroll
            for (int k = 0; k < 16; ++k) { const float2 v = sp[k]; s += v.x; q += v.y; }
            const float mu = s * (1.0f / 512.0f); float var = q * (1.0f / 512.0f) - mu * mu; var = var > 0.f ? var : 0.f;
            ST[tid] = (f32x2){mu, rsqrtf(var + 1e-5f)}; }
        __syncthreads();
        {
            float u0[8], u1[8], u2[8], mg[8], o[8];
            unpack8(*(const u32x4*)(U + (size_t)row * 1024 + c8), u0); unpack8(*(const u32x4*)(MG + (size_t)row * 1024 + c8), mg);
            if (p - 1 >= NPAD) unpack8(*(const u32x4*)(U + (size_t)(row - 1) * 1024 + c8), u1); else {
#pragma unroll
                for (int e = 0; e < 8; ++e) u1[e] = 0.f; }
            if (p - 2 >= NPAD) unpack8(*(const u32x4*)(U + (size_t)(row - 2) * 1024 + c8), u2); else {
#pragma unroll
                for (int e = 0; e < 8; ++e) u2[e] = 0.f; }
#pragma unroll
            for (int e = 0; e < 8; ++e) o[e] = mg[e] * (cb[e] + w0[e] * u2[e] + w1[e] * u1[e] + w2[e] * u0[e]);
            *(u32x4*)(MG + (size_t)row * 1024 + c8) = pack8(o);
        }
#pragma unroll
        for (int qq = 0; qq < 2; ++qq) {
            const int c = (t + 128 * qq) * 8, hd = c >> 9; const f32x2 ms = ST[rl * 4 + hd];
            float rv[8], sz[8], o[8]; unpack8(*(const u32x4*)(RET + (size_t)row * 2048 + c), rv); unpack8(*(const u32x4*)(SZ + (size_t)row * 2048 + c), sz);
            const f32x4 g0 = *(const f32x4*)(P.gn_g + (size_t)l * 2048 + c), g1 = *(const f32x4*)(P.gn_g + (size_t)l * 2048 + c + 4);
#pragma unroll
            for (int e = 0; e < 8; ++e) o[e] = (rv[e] - ms.x) * ms.y * (e < 4 ? g0[e & 3] : g1[e & 3]) * sz[e];
            *(u32x4*)(RET + (size_t)row * 2048 + c) = pack8(o);
        }
    }
    __syncthreads();
}

__global__ void __launch_bounds__(512) hybrid_trunk_fwd(Params P) {
    extern __shared__ __attribute__((aligned(16))) unsigned char lds_raw[];
    LAS unsigned char* lds = (LAS unsigned char*)lds_raw;
    cg::grid_group grid = cg::this_grid();
    unsigned char* ws = P.ws;
    bf16_t* XN = (bf16_t*)(ws + WS_XN); bf16_t* U = (bf16_t*)(ws + WS_U); bf16_t* MG = (bf16_t*)(ws + WS_MG); bf16_t* Q = (bf16_t*)(ws + WS_Q); bf16_t* K = (bf16_t*)(ws + WS_K);
    bf16_t* VH = (bf16_t*)(ws + WS_VH); bf16_t* SZ = (bf16_t*)(ws + WS_SZ);
    const bf16_t* WIN = (const bf16_t*)(ws + WS_WIN); const bf16_t* WCO = (const bf16_t*)(ws + WS_WCO); const bf16_t* WRO = (const bf16_t*)(ws + WS_WRO); const bf16_t* WO = (const bf16_t*)(ws + WS_WO);
    const float* BP = (const float*)(ws + WS_BP); const float* CT = (const float*)(ws + WS_ROPE); const float* ST = CT + 4112 * 128;
    const int G = gridDim.x, c = blockIdx.x;
    for (int l = 0; l < DEPTH; ++l) {
        convert_phase(lds, P, l);
        norm_phase(P, l);
        grid.sync();
        { pg8::Gemm g{XN, WIN, NROW, NA, 1024}; pg8::StaticOrder S; S.init(NROW, NA, G, c); EpiIn E{U, MG, Q, K, VH, SZ, BP, CT, ST};
          pg8::gemm_phase<EpiIn, pg8::StaticOrder>(lds, g, S, E, nullptr); }
        grid.sync();
        scan_phase(lds, P);
        grid.sync();
        elem_phase(lds, P, l);
        { pg8::Gemm g{XN, WIN + (size_t)NA * 1024, NROW, NG, 1024}; pg8::StaticOrder S; S.init(NROW, NG, G, c); EpiOut<0> E{nullptr, Q, K, BP + NA};
          pg8::gemm_phase<EpiOut<0>, pg8::StaticOrder>(lds, g, S, E, nullptr); }
        grid.sync();
        { pg8::Gemm g{MG, WCO, NROW, 1024, 1024}; pg8::StaticOrder S; S.init(NROW, 1024, G, c); EpiOut<1> E{Q, U, nullptr, nullptr};
          pg8::gemm_phase<EpiOut<1>, pg8::StaticOrder>(lds, g, S, E, nullptr); }
        { pg8::Gemm g{VH, WRO, NROW, 1024, 2048}; pg8::StaticOrder S; S.init(NROW, 1024, G, c); EpiOut<2> E{K, U, nullptr, nullptr};
          pg8::gemm_phase<EpiOut<2>, pg8::StaticOrder>(lds, g, S, E, nullptr); }
        grid.sync();
        { pg8::Gemm g{U, WO, NROW, 1024, 1024}; pg8::StaticOrder S; S.init(NROW, 1024, G, c); EpiOut<3> E{nullptr, XN, nullptr, nullptr};
          pg8::gemm_phase<EpiOut<3>, pg8::StaticOrder>(lds, g, S, E, nullptr); }
        grid.sync();
    }
    norm_phase(P, DEPTH);
}

extern "C" void kernel_launch(void* const* d_in, const int* in_sizes, int n_in, void* d_out, int out_size, void* d_ws, size_t ws_size, hipStream_t stream) {
    static int grid = 0;
    if (grid == 0) {
        int dev = 0, cus = 0, per_cu = 0;
        hipGetDevice(&dev); hipDeviceGetAttribute(&cus, hipDeviceAttributeMultiprocessorCount, dev);
        hipFuncSetAttribute((const void*)hybrid_trunk_fwd, hipFuncAttributeMaxDynamicSharedMemorySize, LDS_BYTES);
        hipOccupancyMaxActiveBlocksPerMultiprocessor(&per_cu, (const void*)hybrid_trunk_fwd, 512, LDS_BYTES);
        (void)hipGetLastError();
        if (per_cu < 1) per_cu = 1;
        grid = cus * per_cu;
        if (n_in != 12 || ws_size < WS_END) { fprintf(stderr, "kernel_launch: n_in %d ws %zu need %zu\n", n_in, ws_size, (size_t)WS_END); grid = -1; }
    }
    if (grid < 0) return;
    Params p{};
    p.x = (const float*)d_in[0]; p.meta = (const float*)d_in[1]; p.pre_g = (const float*)d_in[2]; p.w_in = (const float*)d_in[3]; p.b_in = (const float*)d_in[4];
    p.conv_w = (const float*)d_in[5]; p.conv_b = (const float*)d_in[6]; p.w_co = (const float*)d_in[7]; p.gn_g = (const float*)d_in[8]; p.w_ro = (const float*)d_in[9];
    p.w_o = (const float*)d_in[10]; p.post_g = (const float*)d_in[11]; p.out = (float*)d_out; p.ws = (unsigned char*)d_ws;
    void* args[] = {&p};
    hipError_t e = hipLaunchCooperativeKernel((const void*)hybrid_trunk_fwd, dim3(grid), dim3(512), args, LDS_BYTES, stream);
    if (e != hipSuccess) fprintf(stderr, "cooperative launch failed: %s (grid %d)\n", hipGetErrorString(e), grid);
}
```

```cpp
#include <hip/hip_runtime.h>
#include <hip/hip_cooperative_groups.h>
#include <cstdio>
namespace cg = cooperative_groups;
namespace pg8 {
#define PG8_LAS __attribute__((address_space(3)))
typedef unsigned short bf16_t;
typedef short bf16x8 __attribute__((ext_vector_type(8)));
typedef float f32x4 __attribute__((ext_vector_type(4)));
typedef unsigned u32x4 __attribute__((ext_vector_type(4)));
constexpr int BM = 256, BK = 64, HALF = 128, HTB = HALF * BK * 2  , STAGE_BYTES = 8 * HTB, NXCD = 8, WGM = 8;

__host__ __device__ __forceinline__ int lds_byte(int r, int c) { const int st = (r >> 4) * 2 + (c >> 5), rr = r & 15, cc = c & 31, ob = rr * 64 + cc * 2; return st * 1024 + (ob ^ (((ob >> 9) & 1) << 5)); }
__host__ __device__ __forceinline__ void stage_rc(int b, int& R, int& C) { const int st = b / 1024, sb = b % 1024, swz = sb ^ (((sb >> 9) & 1) << 5); R = (st >> 1) * 16 + swz / 64; C = (st & 1) * 32 + (swz % 64) / 2; }
__host__ __device__ __forceinline__ int perm32(int rho) { const int n = rho >> 4, i = rho & 15; return 8 * (i >> 2) + 4 * n + (i & 3); }

struct Unit { int pm, pn; };
struct Gemm { const bf16_t* A; const bf16_t* Bt; int M, N, K; };

struct StaticOrder {
    int nM, nN, nwg, G, c;
    __host__ __device__ void init(int M, int N, int G_, int c_) { nM = M / BM; nN = N / BM; nwg = nM * nN; G = G_; c = c_; }
    __host__ __device__ bool next(int i, Unit& u) const {
        const long L = (long)i * G + c; if (L >= nwg) return false;
        int wgid = (int)L; { const int q = nwg / NXCD, r = nwg % NXCD, xcd = wgid % NXCD, off = wgid / NXCD; wgid = (xcd < r ? xcd * (q + 1) : r * (q + 1) + (xcd - r) * q) + off; }
        const int nig = WGM * nN, gid = wgid / nig, fm = gid * WGM, gsz = (nM - fm) < WGM ? (nM - fm) : WGM;
        u.pm = fm + ((wgid % nig) % gsz); u.pn = (wgid % nig) / gsz; return true;
    }
    __device__ __forceinline__ void a_ready(const Unit&) const {}
    __device__ __forceinline__ void done(const Unit&) const {}
};
struct CountedOrder : StaticOrder {
    const unsigned* ready; unsigned need; unsigned* tmo;
    __device__ __forceinline__ void a_ready(const Unit& u) const {
        if (threadIdx.x < 64) {
            const unsigned long long t0 = __builtin_amdgcn_s_memrealtime(); unsigned polls = 0;
            while ((unsigned)__builtin_amdgcn_readfirstlane(__hip_atomic_load(ready + 64 * u.pm, __ATOMIC_RELAXED, __HIP_MEMORY_SCOPE_AGENT)) < need) {
                if ((++polls & 255u) == 0u && __builtin_amdgcn_readfirstlane(__hip_atomic_load(tmo, __ATOMIC_RELAXED, __HIP_MEMORY_SCOPE_AGENT)) != 0u) break;
                if (__builtin_amdgcn_s_memrealtime() - t0 > 2000000ull) {
                    if (threadIdx.x == 0) { unsigned expect = 0u; __hip_atomic_compare_exchange_strong(tmo + 1, &expect, 0x600u | (unsigned)(u.pm & 0xff), __ATOMIC_RELAXED, __ATOMIC_RELAXED, __HIP_MEMORY_SCOPE_AGENT); __hip_atomic_store(tmo, 1u, __ATOMIC_RELAXED, __HIP_MEMORY_SCOPE_AGENT); }
                    break; }
                __builtin_amdgcn_s_sleep(2); }
            __builtin_amdgcn_fence(__ATOMIC_ACQUIRE, "agent");
            asm volatile("s_waitcnt vmcnt(0)" ::: "memory");
        }
#if !defined(BROKEN_HOOK_NO_BARRIER)
        asm volatile("" ::: "memory"); __builtin_amdgcn_s_barrier(); asm volatile("" ::: "memory");
#endif
    }
};

__device__ __forceinline__ unsigned cvt_pk_bf16(float lo, float hi) { unsigned r; asm volatile("v_cvt_pk_bf16_f32 %0, %1, %2" : "=v"(r) : "v"(lo), "v"(hi)); return r; }
typedef float f32x2 __attribute__((ext_vector_type(2)));
__device__ __forceinline__ f32x2 gelu_pk(f32x2 v) {
    const f32x2 av = __builtin_elementwise_abs(v), d = av * 0.2316418882f + 1.0f;
    f32x2 t; t.x = __builtin_amdgcn_rcpf(d.x); t.y = __builtin_amdgcn_rcpf(d.y);
    f32x2 q = t * 0.5307027145f + (-0.7265760135f); q = q * t + 0.7107068705f; q = q * t + (-0.142248368f); q = q * t + 0.127414796f; q = q * t;
    const f32x2 s = (v * v) * (-0.72134752044f);
    f32x2 e; e.x = __builtin_amdgcn_exp2f(s.x); e.y = __builtin_amdgcn_exp2f(s.y);
    const f32x2 m = v * (q * e), r = v - m;
    f32x2 o; o.x = v.x < 0.f ? m.x : r.x; o.y = v.y < 0.f ? m.y : r.y; return o;
}

template <class Epi, class Sched, bool STAMP = false>
__device__ __forceinline__ void gemm_phase(PG8_LAS unsigned char* lds, const Gemm g, const Sched& S, const Epi& E, unsigned long long* stamps) {
    int tid_l = threadIdx.x; asm volatile("" : "+v"(tid_l));
    const int tid = tid_l, wid = __builtin_amdgcn_readfirstlane(tid >> 6), lane = tid & 63, wr = wid >> 2, wc = wid & 3, fr = lane & 15, fq = lane >> 4;
    const int K = g.K, nt = K / BK;
    int ts_lo = 0, ts_hi = 0, nts = 0; const unsigned long long rt_entry = STAMP ? (unsigned long long)wall_clock64() : 0ull;
#define PG8_STAMP() do { if (STAMP && wid == 0 && nts < 64) { const unsigned long long _c = (unsigned long long)clock64(); \
        ts_lo = (lane == nts) ? (int)(unsigned)_c : ts_lo; ts_hi = (lane == nts) ? (int)(unsigned)(_c >> 32) : ts_hi; ++nts; } } while (0)
    PG8_STAMP();
    unsigned voffA[2], voffB[2];
#pragma unroll
    for (int i = 0; i < 2; ++i) { int R, C; stage_rc(tid * 16 + i * 8192, R, C); const int Rb = Epi::PERM ? ((R & ~31) + perm32(R & 31)) : R;
        voffA[i] = (unsigned)(R * K + C) * 2u; voffB[i] = (unsigned)(Rb * K + C) * 2u; }
    const size_t kstep = (size_t)(BK * 2);
    const size_t hstep = (size_t)HALF * K * 2;
    const size_t tstep = 2 * hstep;
    const unsigned ldsw = (unsigned)wid * 1024u;
    const int aoff = lds_byte(wr * 64 + fr, fq * 8), boff = lds_byte(wc * 32 + fr, fq * 8);
#define PG8_SA(b, h) (((b) * 2 + (h)) * HTB)
#define PG8_SB(b, h) ((4 + (b) * 2 + (h)) * HTB)
#define PG8_STAGE(bufoff, gbase, voff) do { _Pragma("unroll") for (int _i = 0; _i < 2; ++_i) \
        __builtin_amdgcn_global_load_lds((const unsigned*)((const char*)(gbase) + (voff)[_i]), (PG8_LAS unsigned*)(lds + (bufoff) + ldsw + _i * 8192), 16, 0, 0); } while (0)
#define PG8_LDA(dst, b, h) do { _Pragma("unroll") for (int m = 0; m < 4; ++m) _Pragma("unroll") for (int k = 0; k < 2; ++k) dst[m][k] = *(const PG8_LAS bf16x8*)(lds + PG8_SA(b, h) + aoff + m * 2048 + k * 1024); } while (0)
#define PG8_LDB(dst, b, h) do { _Pragma("unroll") for (int n = 0; n < 2; ++n) _Pragma("unroll") for (int k = 0; k < 2; ++k) dst[n][k] = *(const PG8_LAS bf16x8*)(lds + PG8_SB(b, h) + boff + n * 2048 + k * 1024); } while (0)
#define PG8_MMA(ai, bj, At, Bt) do { __builtin_amdgcn_s_setprio(1); _Pragma("unroll") for (int m = 0; m < 4; ++m) _Pragma("unroll") for (int n = 0; n < 2; ++n) _Pragma("unroll") for (int k = 0; k < 2; ++k) \
        acc[ai][bj][m][n] = __builtin_amdgcn_mfma_f32_16x16x32_bf16(Bt[n][k], At[m][k], acc[ai][bj][m][n], 0, 0, 0); __builtin_amdgcn_s_setprio(0); } while (0)
#define PG8_WAIT_V(n) asm volatile("s_waitcnt vmcnt(" #n ")" ::: "memory")
#define PG8_WAIT_L(n) asm volatile("s_waitcnt lgkmcnt(" #n ")" ::: "memory")
#define PG8_BAR __builtin_amdgcn_s_barrier()
#define PG8_SCHED __builtin_amdgcn_sched_barrier(0)
    Unit cur, nxt; int ui = 0;
    if (!S.next(0, cur)) return;
    f32x4 acc[2][2][4][2];
#pragma unroll
    for (int a = 0; a < 2; ++a)
#pragma unroll
        for (int b = 0; b < 2; ++b)
#pragma unroll
            for (int m = 0; m < 4; ++m)
#pragma unroll
                for (int n = 0; n < 2; ++n) acc[a][b][m][n] = (f32x4){0.f, 0.f, 0.f, 0.f};
    bf16x8 At[4][2], B0[2][2], B1[2][2];
    const char* cA = (const char*)g.A + (size_t)cur.pm * tstep; const char* cB = (const char*)g.Bt + (size_t)cur.pn * tstep;
    S.a_ready(cur);
    PG8_STAGE(PG8_SB(0, 0), cB, voffB); PG8_STAGE(PG8_SA(0, 0), cA, voffA); PG8_STAGE(PG8_SB(0, 1), cB + hstep, voffB); PG8_STAGE(PG8_SA(0, 1), cA + hstep, voffA);
    if (wr == 1) PG8_BAR;
    PG8_WAIT_V(4); PG8_BAR;
    PG8_STAGE(PG8_SB(1, 0), cB + kstep, voffB); PG8_STAGE(PG8_SA(1, 0), cA + kstep, voffA); PG8_STAGE(PG8_SB(1, 1), cB + hstep + kstep, voffB);
    PG8_WAIT_V(6); PG8_BAR;
    PG8_STAMP();
    for (;;) {
        const bool has_next = S.next(ui + 1, nxt);
        const char* nA = has_next ? (const char*)g.A + (size_t)nxt.pm * tstep : cA; const char* nB = has_next ? (const char*)g.Bt + (size_t)nxt.pn * tstep : cB;
        for (int t = 0; t < nt; t += 2) {
            const bool last = (t == nt - 2);
            const char* a1 = cA + (size_t)(t + 1) * kstep;
            const char* a2 = last ? nA : cA + (size_t)(t + 2) * kstep; const char* b2 = last ? nB : cB + (size_t)(t + 2) * kstep;
            const char* a3 = a2 + kstep; const char* b3 = b2 + kstep;
            if (last && has_next) S.a_ready(nxt);
            PG8_LDB(B0, 0, 0); PG8_SCHED; PG8_LDA(At, 0, 0); PG8_STAGE(PG8_SA(1, 1), a1 + hstep, voffA);
            PG8_WAIT_L(8); PG8_BAR; PG8_WAIT_L(0); PG8_MMA(0, 0, At, B0); PG8_BAR; PG8_SCHED;
            PG8_LDB(B1, 0, 1); PG8_STAGE(PG8_SB(0, 0), b2, voffB);
            PG8_BAR; PG8_WAIT_L(0); PG8_MMA(0, 1, At, B1); PG8_BAR;
            PG8_LDA(At, 0, 1); PG8_STAGE(PG8_SA(0, 0), a2, voffA);
            PG8_BAR; PG8_WAIT_L(0); PG8_MMA(1, 0, At, B0); PG8_BAR; PG8_SCHED;
            PG8_STAGE(PG8_SB(0, 1), b2 + hstep, voffB);
            PG8_WAIT_V(6); PG8_BAR; PG8_MMA(1, 1, At, B1); PG8_BAR;
            PG8_LDB(B0, 1, 0); PG8_SCHED; PG8_LDA(At, 1, 0); PG8_STAGE(PG8_SA(0, 1), a2 + hstep, voffA);
            PG8_WAIT_L(8); PG8_BAR; PG8_WAIT_L(0); PG8_MMA(0, 0, At, B0); PG8_BAR; PG8_SCHED;
            PG8_LDB(B1, 1, 1); PG8_STAGE(PG8_SB(1, 0), b3, voffB);
            PG8_BAR; PG8_WAIT_L(0); PG8_MMA(0, 1, At, B1); PG8_BAR;
            PG8_LDA(At, 1, 1); PG8_STAGE(PG8_SA(1, 0), a3, voffA);
            PG8_BAR; PG8_WAIT_L(0); PG8_MMA(1, 0, At, B0); PG8_BAR; PG8_SCHED;
            PG8_STAGE(PG8_SB(1, 1), b3 + hstep, voffB);
            PG8_WAIT_V(6); PG8_BAR; PG8_MMA(1, 1, At, B1); PG8_BAR;
        }
        PG8_STAMP();
        if constexpr (!Epi::AFTER_DRAIN) { E(acc, cur, wr, wc, fr, fq); S.done(cur); }
        PG8_STAMP();
        if (!has_next) break;
#pragma unroll
        for (int a = 0; a < 2; ++a)
#pragma unroll
            for (int b = 0; b < 2; ++b)
#pragma unroll
                for (int m = 0; m < 4; ++m)
#pragma unroll
                    for (int n = 0; n < 2; ++n) acc[a][b][m][n] = (f32x4){0.f, 0.f, 0.f, 0.f};
        cur = nxt; cA = nA; cB = nB; ++ui;
    }
    PG8_WAIT_V(0);
    if (wr == 0) PG8_BAR;
    PG8_BAR;
    if constexpr (Epi::AFTER_DRAIN) { E.fused(acc, cur, wr, wc, fr, fq, lds, wid, lane); S.done(cur); }
    PG8_STAMP();
    if (STAMP && wid == 0) { stamps[lane] = lane < nts ? (((unsigned long long)(unsigned)ts_hi << 32) | (unsigned)ts_lo) : 0ull;
        if (lane == 62) stamps[62] = rt_entry; if (lane == 63) stamps[63] = (unsigned long long)wall_clock64(); }
#undef PG8_STAMP
#undef PG8_SA
#undef PG8_SB
#undef PG8_STAGE
#undef PG8_LDA
#undef PG8_LDB
#undef PG8_MMA
#undef PG8_WAIT_V
#undef PG8_WAIT_L
#undef PG8_BAR
#undef PG8_SCHED
}
}
__device__ const double INV_REV[128] = {0.15915494309189535,0.14810514021707516,0.13782250260398285,0.1282537675342271,0.11934937021124886,0.11106318702115607,0.10335229661843406,0.096176757598987819,0.089499401608891013,0.083285640817172504,0.077503288755374058,0.072122393595852222,0.067115083005227255,0.062455419769340485,0.058119267441876246,0.054084165320725783,0.050329212104487035,0.04683495762645621,0.04358330210530733,0.040557402390591489,0.037741584717419771,0.035121263518410453,0.032682865872356998,0.030413761198270856,0.028302195830623399,0.02633723213689523,0.024508691862069852,0.022807103406603451,0.02122365276477766,0.019750137869302395,0.018378926105679667,0.01710291477625845,0.015915494309189534,0.014810514021707515,0.013782250260398284,0.012825376753422709,0.011934937021124886,0.011106318702115607,0.010335229661843406,0.0096176757598987819,0.0089499401608891024,0.0083285640817172511,0.0077503288755374055,0.0072122393595852232,0.0067115083005227253,0.0062455419769340478,0.0058119267441876241,0.0054084165320725779,0.0050329212104487037,0.0046834957626456213,0.0043583302105307331,0.0040557402390591487,0.0037741584717419772,0.0035121263518410454,0.0032682865872356993,0.0030413761198270859,0.0028302195830623399,0.0026337232136895228,0.0024508691862069852,0.0022807103406603446,0.0021223652764777662,0.0019750137869302396,0.0018378926105679667,0.0017102914776258452,0.0015915494309189536,0.0014810514021707515,0.0013782250260398288,0.0012825376753422709,0.0011934937021124885,0.0011106318702115607,0.0010335229661843405,0.00096176757598987806,0.00089499401608891024,0.00083285640817172503,0.00077503288755374051,0.00072122393595852228,0.0006711508300522726,0.00062455419769340487,0.00058119267441876239,0.00054084165320725773,0.00050329212104487033,0.00046834957626456218,0.00043583302105307329,0.00040557402390591486,0.00037741584717419774,0.00035121263518410453,0.00032682865872356992,0.0003041376119827086,0.00028302195830623395,0.00026337232136895234,0.00024508691862069854,0.00022807103406603446,0.00021223652764777661,0.00019750137869302395,0.00018378926105679666,0.00017102914776258454,0.00015915494309189535,0.00014810514021707514,0.00013782250260398286,0.00012825376753422709,0.00011934937021124886,0.00011106318702115607,0.00010335229661843406,9.6176757598987812e-05,8.9499401608891018e-05,8.3285640817172505e-05,7.7503288755374056e-05,7.2122393595852225e-05,6.7115083005227254e-05,6.2455419769340487e-05,5.8119267441876239e-05,5.4084165320725784e-05,5.0329212104487035e-05,4.6834957626456207e-05,4.3583302105307322e-05,4.0557402390591481e-05,3.7741584717419777e-05,3.5121263518410453e-05,3.2682865872356999e-05,3.0413761198270857e-05,2.8302195830623396e-05,2.6337232136895232e-05,2.4508691862069852e-05,2.2807103406603447e-05,2.1223652764777659e-05,1.9750137869302396e-05,1.8378926105679668e-05,1.7102914776258452e-05};

using pg8::bf16_t; using pg8::bf16x8; using pg8::f32x4; using pg8::u32x4; using pg8::Unit;
#define LAS __attribute__((address_space(3)))
typedef float f32x16 __attribute__((ext_vector_type(16)));
typedef short s16x4 __attribute__((ext_vector_type(4)));
typedef unsigned u32x2 __attribute__((ext_vector_type(2)));
typedef float f32x2 __attribute__((ext_vector_type(2)));

constexpr int DM = 1024, NB = 8, SEQ = 4096, LP = 4160, NPAD = 48, NROW = NB * LP;
constexpr int NREAL = NB * SEQ;
constexpr int DIN = 12288, DEPTH = 4, NA = 10240, NG = 2048, NCH = 65;
constexpr int LDS_BIAS = 131072 + 16, LDS_BYTES = LDS_BIAS + 12288 * 2;
constexpr size_t SZ1 = (size_t)NROW * 1024 * 2;
constexpr size_t WS_XN = 0, WS_U = SZ1, WS_MG = 2 * SZ1, WS_Q = 3 * SZ1, WS_K = 4 * SZ1, WS_VH = 5 * SZ1, WS_SZ = 7 * SZ1;
constexpr size_t WS_WIN = 9 * SZ1, WS_WCO = WS_WIN + (size_t)DIN * 1024 * 2, WS_WRO = WS_WCO + 1024 * 1024 * 2, WS_WO = WS_WRO + 1024 * 2048 * 2;
constexpr size_t WS_BP = WS_WO + 1024 * 1024 * 2, WS_ROPE = WS_BP + DIN * 4, WS_GA = WS_ROPE + 2 * (size_t)4112 * 128 * 4, WS_GB = WS_GA + SZ1;
constexpr size_t WS_STAT = WS_GB + SZ1, WS_HMETA = WS_STAT + 4096, WS_BAR = WS_HMETA + 8 * 16 * 1024 * 4, WS_END = WS_BAR + 16384;

struct Params { const float* x; const float* meta; const float* pre_g; const float* w_in; const float* b_in; const float* conv_w; const float* conv_b;
                const float* w_co; const float* gn_g; const float* w_ro; const float* w_o; const float* post_g; float* out; unsigned char* ws; };

__device__ __forceinline__ void row_bp(int r, int& b, int& p) { if (r < NREAL) { b = r >> 12; p = 64 + (r & 4095); } else { const int rr = r - NREAL; b = rr >> 6; p = rr & 63; } }
__device__ __forceinline__ int bp_row(int b, int p) { return p >= 64 ? (b << 12) + (p - 64) : NREAL + (b << 6) + p; }
__device__ __forceinline__ float bflo(unsigned u) { return __uint_as_float(u << 16); }
__device__ __forceinline__ float bfhi(unsigned u) { return __uint_as_float(u & 0xffff0000u); }
typedef __bf16 bf16x2_t __attribute__((ext_vector_type(2)));
__device__ __forceinline__ unsigned pk(float lo, float hi) { typedef float f2_t __attribute__((ext_vector_type(2))); const bf16x2_t v = __builtin_convertvector((f2_t){lo, hi}, bf16x2_t); return __builtin_bit_cast(unsigned, v); }
__device__ __forceinline__ void unpack8(const u32x4 r, float (&f)[8]) { f[0] = bflo(r.x); f[1] = bfhi(r.x); f[2] = bflo(r.y); f[3] = bfhi(r.y); f[4] = bflo(r.z); f[5] = bfhi(r.z); f[6] = bflo(r.w); f[7] = bfhi(r.w); }
__device__ __forceinline__ u32x4 pack8(const float (&f)[8]) { u32x4 r; r.x = pk(f[0], f[1]); r.y = pk(f[2], f[3]); r.z = pk(f[4], f[5]); r.w = pk(f[6], f[7]); return r; }
__device__ __forceinline__ float ex2(float x) { return __builtin_amdgcn_exp2f(x); }
__device__ __forceinline__ float silu_f(float y) { return y * __builtin_amdgcn_rcpf(1.0f + ex2(-1.4426950408889634f * y)); }
__device__ __forceinline__ float sigm_f(float y) { return __builtin_amdgcn_rcpf(1.0f + ex2(-1.4426950408889634f * y)); }
__device__ __forceinline__ float lg_gamma(int hd) { return hd == 0 ? -0.0458036896131f : hd == 1 ? -0.0227200765001f : hd == 2 ? -0.0113153132278f : -0.00564656314114f; }
__device__ __forceinline__ float wave_sum(float v) { for (int o = 32; o >= 1; o >>= 1) v += __shfl_xor(v, o); return v; }
#define LBAR() do { asm volatile("s_waitcnt lgkmcnt(0)" ::: "memory"); __builtin_amdgcn_s_barrier(); asm volatile("" ::: "memory"); } while (0)

struct EpiIn {
    static constexpr bool PERM = true, AFTER_DRAIN = false;
    bf16_t *U, *MG, *Q, *K, *VH, *SZ, *GA, *GB; const LAS bf16_t* bperm; const float* ct; const float* st;
    __device__ __forceinline__ void operator()(const f32x4 (&acc)[2][2][4][2], const Unit& u, int wr, int wc, int fr, int fq) const {
        const int pn = u.pn, cc = wc * 32 + 8 * fq;
        float irv[8];
#pragma unroll
        for (int e = 0; e < 8; ++e) irv[e] = (pn >= 16 && pn < 24) ? ex2(-0.10381025296523007f * (float)(cc + e) - 2.651496129472319f) : 0.f;
        f32x4 bv[2][2];
#pragma unroll
        for (int bj = 0; bj < 2; ++bj)
#pragma unroll
            for (int n = 0; n < 2; ++n) { const u32x2 raw = *(const LAS u32x2*)(bperm + pn * 256 + bj * 128 + cc + 4 * n); bv[bj][n] = (f32x4){bflo(raw.x), bfhi(raw.x), bflo(raw.y), bfhi(raw.y)}; }
#pragma unroll
        for (int ai = 0; ai < 2; ++ai)
#pragma unroll
            for (int m = 0; m < 4; ++m) {
                const int r = u.pm * 256 + ai * 128 + wr * 64 + m * 16 + fr; int b, p; row_bp(r, b, p);
                float x[8], y[8], o1[8], o2[8];
#pragma unroll
                for (int n = 0; n < 2; ++n)
#pragma unroll
                    for (int j = 0; j < 4; ++j) { x[4 * n + j] = acc[ai][0][m][n][j] + bv[0][n][j]; y[4 * n + j] = acc[ai][1][m][n][j] + bv[1][n][j]; }
                if (pn < 8) {
#pragma unroll
                    for (int e = 0; e < 8; ++e) o1[e] = x[e] * y[e];
                    *(u32x4*)(U + (size_t)r * 1024 + pn * 128 + cc) = pack8(o1);
                } else if (pn < 16) {
#pragma unroll
                    for (int e = 0; e < 8; ++e) o1[e] = x[e] * silu_f(y[e]);
                    *(u32x4*)(MG + (size_t)r * 1024 + (pn - 8) * 128 + cc) = pack8(o1);
                } else if (pn < 24) {
                    const bool isk = pn >= 20; const int hd = isk ? pn - 20 : pn - 16; const float sc = isk ? 0.0625f : 1.0f;
                    if (p >= NPAD) {
                        const float posf = (float)(p - NPAD);
#pragma unroll
                        for (int e = 0; e < 8; ++e) { const float fr_ = __builtin_amdgcn_fractf(posf * irv[e]); const float c = __builtin_amdgcn_cosf(fr_), s = __builtin_amdgcn_sinf(fr_);
                            o1[e] = (x[e] * c - y[e] * s) * sc; o2[e] = (x[e] * s + y[e] * c) * sc; }
                    } else {
#pragma unroll
                        for (int e = 0; e < 8; ++e) { o1[e] = 0.f; o2[e] = 0.f; }
                    }
                    bf16_t* dst = (isk ? K : Q) + (size_t)((b * 4 + hd) * LP + p) * 256 + cc;
                    *(u32x4*)dst = pack8(o1); *(u32x4*)(dst + 128) = pack8(o2);
                } else if (pn < 32) {
                    const int vt = pn - 24; const float dec = (p >= NPAD) ? ex2(lg_gamma(vt >> 1) * (float)(63 - (p & 63))) : 0.f;
#pragma unroll
                    for (int e = 0; e < 8; ++e) { o1[e] = x[e] * dec; o2[e] = y[e] * dec; }
                    const int ch1 = (vt & 1) * 256 + cc, ch2 = ch1 + 128, bh8 = (b * 4 + (vt >> 1)) * 8;
                    *(u32x4*)(VH + (size_t)((bh8 + (ch1 >> 6)) * LP + p) * 64 + (ch1 & 63)) = pack8(o1);
                    *(u32x4*)(VH + (size_t)((bh8 + (ch2 >> 6)) * LP + p) * 64 + (ch2 & 63)) = pack8(o2);
                } else if (pn < 40) {
#pragma unroll
                    for (int e = 0; e < 8; ++e) { o1[e] = x[e]; o2[e] = y[e]; }
                    bf16_t* dst = SZ + (size_t)r * 2048 + (pn - 32) * 256 + cc;
                    *(u32x4*)dst = pack8(o1); *(u32x4*)(dst + 128) = pack8(o2);
                } else {
#pragma unroll
                    for (int e = 0; e < 8; ++e) { o1[e] = x[e]; o2[e] = y[e]; }
                    bf16_t* dst = (pn < 44 ? GA : GB) + (size_t)r * 1024 + (pn & 3) * 256 + cc;
                    *(u32x4*)dst = pack8(o1); *(u32x4*)(dst + 128) = pack8(o2);
                }
            }
    }
};
template <int MODE> struct EpiOut {
    static constexpr bool PERM = true, AFTER_DRAIN = false;
    const bf16_t* G; bf16_t* Y; bf16_t* Y2; const float* bias;
    __device__ __forceinline__ void operator()(const f32x4 (&acc)[2][2][4][2], const Unit& u, int wr, int wc, int fr, int fq) const {
        const int cc = wc * 32 + 8 * fq;
#pragma unroll
        for (int ai = 0; ai < 2; ++ai) {
            u32x4 gq[4][2], yq[4][2];
            if (MODE == 1 || MODE == 2) {
#pragma unroll
                for (int m = 0; m < 4; ++m)
#pragma unroll
                    for (int bj = 0; bj < 2; ++bj) { const size_t off = (size_t)(u.pm * 256 + ai * 128 + wr * 64 + m * 16 + fr) * 1024 + u.pn * 256 + bj * 128 + cc;
                        gq[m][bj] = __builtin_nontemporal_load((const u32x4*)(G + off)); if (MODE == 2) yq[m][bj] = *(const u32x4*)(Y + off); }
                __builtin_amdgcn_sched_barrier(0);
            }
#pragma unroll
            for (int m = 0; m < 4; ++m) {
                const int r = u.pm * 256 + ai * 128 + wr * 64 + m * 16 + fr;
#pragma unroll
                for (int bj = 0; bj < 2; ++bj) {
                    float v[8], o[8];
#pragma unroll
                    for (int n = 0; n < 2; ++n)
#pragma unroll
                        for (int j = 0; j < 4; ++j) v[4 * n + j] = acc[ai][bj][m][n][j];
                    if (MODE == 0) {
                        const int c = u.pn * 256 + bj * 128 + cc;
                        const f32x4 b0 = *(const f32x4*)(bias + c), b1 = *(const f32x4*)(bias + c + 4);
#pragma unroll
                        for (int e = 0; e < 8; ++e) o[e] = sigm_f(v[e] + (e < 4 ? b0[e & 3] : b1[e & 3]));
                        bf16_t* dst = (u.pn < 4 ? Y : Y2) + (size_t)r * 1024 + (u.pn & 3) * 256 + bj * 128 + cc;
                        *(u32x4*)dst = pack8(o);
                    } else {
                        const size_t off = (size_t)r * 1024 + u.pn * 256 + bj * 128 + cc;
                        if (MODE == 3) {
#pragma unroll
                            for (int e = 0; e < 8; ++e) o[e] = v[e];
                        } else {
                            float g[8]; unpack8(gq[m][bj], g);
#pragma unroll
                            for (int e = 0; e < 8; ++e) g[e] = sigm_f(g[e]);
                            if (MODE == 1) {
#pragma unroll
                                for (int e = 0; e < 8; ++e) o[e] = g[e] * v[e];
                            } else {
                                float yv[8]; unpack8(yq[m][bj], yv);
#pragma unroll
                                for (int e = 0; e < 8; ++e) o[e] = yv[e] + g[e] * v[e];
                            }
                        }
                        *(u32x4*)(Y + off) = pack8(o);
                    }
                }
            }
        }
    }
};

template <int MODE> __device__ __forceinline__ void meta_gemm(const bf16_t* A, const bf16_t* Bt, int K, int N, const bf16_t* G, bf16_t* Y, bf16_t* Y2, const float* bias) {
    int tid_l = threadIdx.x; asm volatile("" : "+v"(tid_l));
    const int lane = tid_l & 63, wv = tid_l >> 6, lr = lane & 15, g = lane >> 4;
    const int ntile = 8 * (N >> 4);
    for (int t = blockIdx.x * 8 + wv; t < ntile; t += gridDim.x * 8) {
        const int bt = t & 7, ct = t >> 3, row0 = NREAL + bt * 64 + NPAD;
        const bf16_t* ap = A + (size_t)(row0 + lr) * K + 8 * g; const bf16_t* bp = Bt + (size_t)(16 * ct + lr) * K + 8 * g;
        f32x4 acc = (f32x4){0.f, 0.f, 0.f, 0.f};
        for (int kb = 0; kb < K / 32; kb += 16) {
            bf16x8 af[16], bfr[16];
#pragma unroll
            for (int i = 0; i < 16; ++i) { af[i] = *(const bf16x8*)(ap + 32 * (kb + i)); bfr[i] = *(const bf16x8*)(bp + 32 * (kb + i)); }
            __builtin_amdgcn_sched_barrier(0);
#pragma unroll
            for (int i = 0; i < 16; ++i) acc = __builtin_amdgcn_mfma_f32_16x16x32_bf16(af[i], bfr[i], acc, 0, 0, 0);
            __builtin_amdgcn_sched_barrier(0);
        }
        const int col = 16 * ct + lr;
#pragma unroll
        for (int rg = 0; rg < 4; ++rg) {
            const int row = row0 + 4 * g + rg; const float v = acc[rg]; float o;
            if (MODE == 0) { o = sigm_f(v + bias[col]); (col < 1024 ? Y : Y2)[(size_t)row * 1024 + (col & 1023)] = (bf16_t)(pk(o, 0.f) & 0xffffu); }
            else { const size_t off = (size_t)row * 1024 + col;
                if (MODE == 3) o = v; else { const float gv = sigm_f(bflo((unsigned)G[off])); o = gv * v; if (MODE == 2) o += bflo((unsigned)Y[off]); }
                Y[off] = (bf16_t)(pk(o, 0.f) & 0xffffu); }
        }
    }
}

__device__ __forceinline__ int dest_of_orig(int n) {
    if (n >= 4096) return n;
    const int grp = n >> 10, j = n & 1023, t = j >> 7, cc = j & 127;
    const int tile = (grp == 0 || grp == 2) ? t : 8 + t, half = (grp >= 2) ? 1 : 0;
    return tile * 256 + half * 128 + cc;
}
__device__ __forceinline__ void convert_phase(LAS unsigned char* lds, const Params& P, int l) {
    int tid_l = threadIdx.x; asm volatile("" : "+v"(tid_l));
    const int tid = tid_l; LAS float* T = (LAS float*)lds;
    unsigned char* ws = P.ws;
    for (int t4 = blockIdx.x * 4; t4 < 4096; t4 += gridDim.x * 4) {
        const int k0 = tid >> 4, n4 = (tid & 15) * 4;
        f32x4 ld[4][2];
#pragma unroll
        for (int q = 0; q < 4; ++q) {
            const int t = t4 + q; const float* src; int N, kb, nb;
            if (t < 3072) { src = P.w_in + (size_t)l * 1024 * DIN; N = DIN; kb = t / 192; nb = t % 192; }
            else if (t < 3328) { const int u = t - 3072; src = P.w_co + (size_t)l * 1024 * 1024; N = 1024; kb = u >> 4; nb = u & 15; }
            else if (t < 3840) { const int u = t - 3328; src = P.w_ro + (size_t)l * 2048 * 1024; N = 1024; kb = u >> 4; nb = u & 15; }
            else { const int u = t - 3840; src = P.w_o + (size_t)l * 1024 * 1024; N = 1024; kb = u >> 4; nb = u & 15; }
#pragma unroll
            for (int i = 0; i < 2; ++i) ld[q][i] = __builtin_nontemporal_load((const f32x4*)(src + (size_t)(kb * 64 + k0 + 32 * i) * N + nb * 64 + n4));
            if (t < 3072 && kb == 0 && tid < 64) ((float*)(ws + WS_BP))[dest_of_orig(nb * 64 + tid)] = P.b_in[(size_t)l * DIN + nb * 64 + tid];
        }
#pragma unroll
        for (int q = 0; q < 4; ++q)
#pragma unroll
            for (int i = 0; i < 2; ++i)
#pragma unroll
                for (int j = 0; j < 4; ++j) T[q * 4160 + (n4 + j) * 65 + k0 + 32 * i] = ld[q][i][j];
        __syncthreads();
#pragma unroll
        for (int q = 0; q < 4; ++q) {
            const int t = t4 + q; bf16_t* dst; int K, kb, nb; bool perm = false;
            if (t < 3072) { dst = (bf16_t*)(ws + WS_WIN); K = 1024; kb = t / 192; nb = t % 192; perm = true; }
            else if (t < 3328) { const int u = t - 3072; dst = (bf16_t*)(ws + WS_WCO); K = 1024; kb = u >> 4; nb = u & 15; }
            else if (t < 3840) { const int u = t - 3328; dst = (bf16_t*)(ws + WS_WRO); K = 2048; kb = u >> 4; nb = u & 15; }
            else { const int u = t - 3840; dst = (bf16_t*)(ws + WS_WO); K = 1024; kb = u >> 4; nb = u & 15; }
            const int n = tid >> 3, kc = (tid & 7) * 8; float f[8];
#pragma unroll
            for (int j = 0; j < 8; ++j) f[j] = T[q * 4160 + n * 65 + kc + j];
            const int drow = perm ? dest_of_orig(nb * 64 + n) : nb * 64 + n;
            *(u32x4*)(dst + (size_t)drow * K + kb * 64 + kc) = pack8(f);
        }
        __syncthreads();
    }
}

__device__ __forceinline__ void norm_phase(const Params& P, int l) {
    int tid_l = threadIdx.x; asm volatile("" : "+v"(tid_l));
    const int tid = tid_l, lane = tid & 63, wv = tid >> 6;
    bf16_t* XN = (bf16_t*)(P.ws + WS_XN); float* HMETA = (float*)(P.ws + WS_HMETA);
    for (int row = blockIdx.x * 8 + wv; row < NROW; row += gridDim.x * 8) {
        int b, p; row_bp(row, b, p);
        bf16_t* xr = XN + (size_t)row * 1024;
        if (l == DEPTH && p < 64) continue;
        if (p < NPAD) {
            if (l < DEPTH) {
#pragma unroll
                for (int k = 0; k < 4; ++k) *(u32x2*)(xr + 256 * k + 4 * lane) = (u32x2){0u, 0u};
            }
            continue;
        }
        float* hp = p >= 64 ? P.out + (size_t)(b * SEQ + p - 64) * 1024 : HMETA + (size_t)(b * 16 + p - NPAD) * 1024;
        f32x4 v[4];
        if (l == 0) {
            const float* src = p >= 64 ? P.x + (size_t)(b * SEQ + p - 64) * 1024 : P.meta + (size_t)(p - NPAD) * 1024;
#pragma unroll
            for (int k = 0; k < 4; ++k) v[k] = __builtin_nontemporal_load((const f32x4*)(src + 256 * k + 4 * lane));
        } else {
            f32x4 o[4], hv[4]; float ss = 0.f;
            const float* hsrc = (l == 1 && p >= 64) ? P.x + (size_t)(b * SEQ + p - 64) * 1024 : hp;
#pragma unroll
            for (int k = 0; k < 4; ++k) hv[k] = __builtin_nontemporal_load((const f32x4*)(hsrc + 256 * k + 4 * lane));
#pragma unroll
            for (int k = 0; k < 4; ++k) { const u32x2 raw = __builtin_nontemporal_load((const u32x2*)(xr + 256 * k + 4 * lane)); o[k] = (f32x4){bflo(raw.x), bfhi(raw.x), bflo(raw.y), bfhi(raw.y)};
                ss += o[k][0] * o[k][0] + o[k][1] * o[k][1] + o[k][2] * o[k][2] + o[k][3] * o[k][3]; }
            ss = wave_sum(ss); const float rs = rsqrtf(ss * (1.0f / 1024.0f) + 1e-6f);
#pragma unroll
            for (int k = 0; k < 4; ++k) { const f32x4 g = *(const f32x4*)(P.post_g + (size_t)(l - 1) * 1024 + 256 * k + 4 * lane);
                v[k] = hv[k] + o[k] * rs * g; }
        }
        if (l != 0 || p < 64) {
#pragma unroll
            for (int k = 0; k < 4; ++k) __builtin_nontemporal_store(v[k], (f32x4*)(hp + 256 * k + 4 * lane));
        }
        if (l == DEPTH) continue;
        float s2 = 0.f;
#pragma unroll
        for (int k = 0; k < 4; ++k) s2 += v[k][0] * v[k][0] + v[k][1] * v[k][1] + v[k][2] * v[k][2] + v[k][3] * v[k][3];
        s2 = wave_sum(s2); const float r2 = rsqrtf(s2 * (1.0f / 1024.0f) + 1e-6f);
#pragma unroll
        for (int k = 0; k < 4; ++k) { const f32x4 g = *(const f32x4*)(P.pre_g + (size_t)l * 1024 + 256 * k + 4 * lane); const f32x4 y = v[k] * r2 * g;
            *(u32x2*)(xr + 256 * k + 4 * lane) = (u32x2){pk(y[0], y[1]), pk(y[2], y[3])}; }
    }
}

__device__ __forceinline__ bf16x8 tr2(LAS unsigned char* a0, LAS unsigned char* a1) {
    const s16x4 t0 = __builtin_amdgcn_ds_read_tr16_b64_v4i16((LAS s16x4*)a0), t1 = __builtin_amdgcn_ds_read_tr16_b64_v4i16((LAS s16x4*)a1);
    return __builtin_shufflevector(t0, t1, 0, 1, 2, 3, 4, 5, 6, 7);
}
__device__ __forceinline__ void scan_phase(LAS unsigned char* lds, const Params& P) {
    constexpr int QP = 528, VP = 144, OFF_Q = 0, OFF_K = 64 * QP, OFF_SB = 2 * 64 * QP, OFF_V = 3 * 64 * QP, OFF_P = OFF_V + 64 * VP, OFF_O = OFF_P + 64 * VP;
    static_assert(OFF_O + 64 * VP <= 131072, "scan LDS");
    int tid_l = threadIdx.x; asm volatile("" : "+v"(tid_l));
    const int tid = tid_l, lane = tid & 63, w = __builtin_amdgcn_readfirstlane(tid >> 6);
    const bf16_t* Q = (const bf16_t*)(P.ws + WS_Q); const bf16_t* K = (const bf16_t*)(P.ws + WS_K); bf16_t* VH = (bf16_t*)(P.ws + WS_VH);
    float2* STAT = (float2*)(P.ws + WS_STAT);
    const int mb = w >> 1, nb0 = 2 * (w & 1), rb = w >> 1, cb0 = 2 * (w & 1);
    for (int cidx = blockIdx.x; cidx < 256; cidx += gridDim.x) {
        const int chain = (cidx & 7) * 32 + (cidx >> 3);
        const int b = chain >> 5, hd = (chain >> 3) & 3, sl = chain & 7; const float lg = lg_gamma(hd);
        f32x16 S[2];
#pragma unroll
        for (int i = 0; i < 16; ++i) { S[0][i] = 0.f; S[1][i] = 0.f; }
        for (int i = tid; i < 64 * QP / 16; i += 512) *(LAS u32x4*)(lds + OFF_SB + 16 * i) = (u32x4){0u, 0u, 0u, 0u};
        u32x4 qr[4], kr[4], vr;
#define SCAN_LOADQ(ci_) do { const bf16_t* qb_ = Q + (size_t)((b * 4 + hd) * LP + 64 * (ci_)) * 256; _Pragma("unroll") for (int i = 0; i < 4; ++i) qr[i] = *(const u32x4*)(qb_ + (tid + 512 * i) * 8); } while (0)
#define SCAN_LOADK(ci_) do { const bf16_t* kb_ = K + (size_t)((b * 4 + hd) * LP + 64 * (ci_)) * 256; _Pragma("unroll") for (int i = 0; i < 4; ++i) kr[i] = *(const u32x4*)(kb_ + (tid + 512 * i) * 8); } while (0)
#define SCAN_VPTR(ci_) (VH + (size_t)(((b * 4 + hd) * 8 + sl) * LP + 64 * (ci_)) * 64 + tid * 8)
#define SCAN_LOADV(ci_) do { vr = __builtin_nontemporal_load((const u32x4*)SCAN_VPTR(ci_)); } while (0)
#define SCAN_LOAD(ci_) do { SCAN_LOADQ(ci_); SCAN_LOADK(ci_); SCAN_LOADV(ci_); } while (0)
#define SCAN_STORE() do { _Pragma("unroll") for (int i = 0; i < 4; ++i) { const int id = tid + 512 * i, row = id >> 5, ch = id & 31; \
            *(LAS u32x4*)(lds + OFF_Q + row * QP + ch * 16) = qr[i]; *(LAS u32x4*)(lds + OFF_K + row * QP + ch * 16) = kr[i]; } \
            *(LAS u32x4*)(lds + OFF_V + (tid >> 3) * VP + (tid & 7) * 16) = vr; } while (0)
        SCAN_LOAD(0); SCAN_STORE(); LBAR();
        for (int ci = 0; ci < NCH; ++ci) {
            int lane_v = lane; asm volatile("" : "+v"(lane_v));
            const int lr = lane_v & 15, g = lane_v >> 4, l31 = lane_v & 31, hh = lane_v >> 5, blk = (lane_v >> 4) & 1, q4 = (lane_v & 15) >> 2, p4 = lane_v & 3;
            if (ci > 0) __builtin_nontemporal_store(*(const LAS u32x4*)(lds + OFF_O + (tid >> 3) * VP + (tid & 7) * 16), (u32x4*)SCAN_VPTR(ci - 1));
            if (ci + 1 < NCH) SCAN_LOADQ(ci + 1);
            float ov[4][2];
            bf16x8 qf[8];
            {
                f32x4 accP[2] = {(f32x4){0.f, 0.f, 0.f, 0.f}, (f32x4){0.f, 0.f, 0.f, 0.f}};
#pragma unroll
                for (int hb = 0; hb < 2; ++hb) {
                    bf16x8 kf[2][4];
#pragma unroll
                    for (int k4 = 0; k4 < 4; ++k4) { const int ks = 4 * hb + k4;
                        qf[ks] = *(const LAS bf16x8*)(lds + OFF_Q + (16 * rb + lr) * QP + (32 * ks + 8 * g) * 2);
#pragma unroll
                        for (int t = 0; t < 2; ++t) kf[t][k4] = *(const LAS bf16x8*)(lds + OFF_K + (16 * (cb0 + t) + lr) * QP + (32 * ks + 8 * g) * 2); }
                    __builtin_amdgcn_sched_barrier(0);
#pragma unroll
                    for (int k4 = 0; k4 < 4; ++k4)
#pragma unroll
                        for (int t = 0; t < 2; ++t) accP[t] = __builtin_amdgcn_mfma_f32_16x16x32_bf16(kf[t][k4], qf[4 * hb + k4], accP[t], 0, 0, 0);
                    __builtin_amdgcn_sched_barrier(0);
                }
                const int n = 16 * rb + lr;
#pragma unroll
                for (int t = 0; t < 2; ++t) { float pv[4];
#pragma unroll
                    for (int rg = 0; rg < 4; ++rg) { const int m = 16 * (cb0 + t) + 4 * g + rg, d = m - n; pv[rg] = accP[t][rg] * ex2(lg * (float)(-64 + (d > 0 ? 2 * d : 0))); }
                    *(LAS u32x2*)(lds + OFF_P + n * VP + (16 * (cb0 + t) + 4 * g) * 2) = (u32x2){pk(pv[0], pv[1]), pk(pv[2], pv[3])}; }
            }
            LBAR();
            if (ci + 1 < NCH) SCAN_LOADK(ci + 1);
            {
                f32x4 accO[2] = {(f32x4){0.f, 0.f, 0.f, 0.f}, (f32x4){0.f, 0.f, 0.f, 0.f}};
                bf16x8 pf[2], vf[2][2];
#pragma unroll
                for (int hb = 0; hb < 2; ++hb) {
                    bf16x8 sf[2][4];
#pragma unroll
                    for (int k4 = 0; k4 < 4; ++k4)
#pragma unroll
                        for (int t = 0; t < 2; ++t) sf[t][k4] = *(const LAS bf16x8*)(lds + OFF_SB + (16 * (cb0 + t) + lr) * QP + (32 * (4 * hb + k4) + 8 * g) * 2);
                    if (hb == 1) {
#pragma unroll
                        for (int ks = 0; ks < 2; ++ks) {
                            pf[ks] = *(const LAS bf16x8*)(lds + OFF_P + (16 * rb + lr) * VP + (32 * ks + 8 * g) * 2);
#pragma unroll
                            for (int t = 0; t < 2; ++t) { LAS unsigned char* base = lds + OFF_V + (32 * ks + 8 * g + q4) * VP + (16 * (cb0 + t) + 4 * p4) * 2; vf[t][ks] = tr2(base, base + 4 * VP); }
                        }
                    }
                    __builtin_amdgcn_sched_barrier(0);
#pragma unroll
                    for (int k4 = 0; k4 < 4; ++k4)
#pragma unroll
                        for (int t = 0; t < 2; ++t) accO[t] = __builtin_amdgcn_mfma_f32_16x16x32_bf16(qf[4 * hb + k4], sf[t][k4], accO[t], 0, 0, 0);
                    __builtin_amdgcn_sched_barrier(0);
                }
#pragma unroll
                for (int ks = 0; ks < 2; ++ks)
#pragma unroll
                    for (int t = 0; t < 2; ++t) accO[t] = __builtin_amdgcn_mfma_f32_16x16x32_bf16(pf[ks], vf[t][ks], accO[t], 0, 0, 0);
#pragma unroll
                for (int rg = 0; rg < 4; ++rg) { const float sc = ex2(lg * (float)(16 * rb + 4 * g + rg + 1)); ov[rg][0] = accO[0][rg] * sc; ov[rg][1] = accO[1][rg] * sc; }
            }
            if (ci + 1 < NCH) SCAN_LOADV(ci + 1);
            {
                bf16x8 af[4], bf[2][4];
#pragma unroll
                for (int ks = 0; ks < 4; ++ks) {
                    LAS unsigned char* ab = lds + OFF_K + (16 * ks + 8 * hh + q4) * QP + (32 * w + 16 * blk + 4 * p4) * 2;
                    af[ks] = tr2(ab, ab + 4 * QP);
#pragma unroll
                    for (int tv = 0; tv < 2; ++tv) { LAS unsigned char* bb = lds + OFF_V + (16 * ks + 8 * hh + q4) * VP + (32 * tv + 16 * blk + 4 * p4) * 2; bf[tv][ks] = tr2(bb, bb + 4 * VP); }
                }
                const float cd = ex2(lg * 64.0f);
                S[0] *= cd; S[1] *= cd;
                __builtin_amdgcn_sched_barrier(0);
#pragma unroll
                for (int ks = 0; ks < 4; ++ks)
#pragma unroll
                    for (int tv = 0; tv < 2; ++tv) S[tv] = __builtin_amdgcn_mfma_f32_32x32x16_bf16(af[ks], bf[tv][ks], S[tv], 0, 0, 0);
            }
            LBAR();
#pragma unroll
            for (int tv = 0; tv < 2; ++tv)
#pragma unroll
                for (int rg = 0; rg < 4; ++rg)
                    *(LAS u32x2*)(lds + OFF_SB + (32 * tv + l31) * QP + (32 * w + 8 * rg + 4 * hh) * 2) = (u32x2){pk(S[tv][4 * rg], S[tv][4 * rg + 1]), pk(S[tv][4 * rg + 2], S[tv][4 * rg + 3])};
#pragma unroll
            for (int rg = 0; rg < 4; ++rg)
#pragma unroll
                for (int t = 0; t < 2; ++t) *(LAS bf16_t*)(lds + OFF_O + (16 * rb + 4 * g + rg) * VP + (16 * (cb0 + t) + lr) * 2) = (bf16_t)(pk(ov[rg][t], 0.f) & 0xffffu);
            if (ci + 1 < NCH) SCAN_STORE();
            LBAR();
        }
        __builtin_nontemporal_store(*(const LAS u32x4*)(lds + OFF_O + (tid >> 3) * VP + (tid & 7) * 16), (u32x4*)SCAN_VPTR(NCH - 1));
        LBAR();
#undef SCAN_LOAD
#undef SCAN_STORE
    }
}

__device__ __forceinline__ void elem_phase(LAS unsigned char* lds, const Params& P, int l) {
    int tid_l = threadIdx.x; asm volatile("" : "+v"(tid_l));
    const int tid = tid_l, lane = tid & 63, wv = tid >> 6;
    const bf16_t* U = (const bf16_t*)(P.ws + WS_U); bf16_t* MG = (bf16_t*)(P.ws + WS_MG); const bf16_t* RET = (const bf16_t*)(P.ws + WS_VH); bf16_t* A2 = (bf16_t*)(P.ws + WS_Q); const bf16_t* SZ = (const bf16_t*)(P.ws + WS_SZ);
    const f32x2* STAT = (const f32x2*)(P.ws + WS_STAT);
    f32x4 cw[2][4][2], gg[4][2];
#pragma unroll
    for (int k = 0; k < 2; ++k) { const int c8 = (lane + 64 * k) * 8;
#pragma unroll
        for (int j = 0; j < 3; ++j) { cw[k][j][0] = *(const f32x4*)(P.conv_w + (size_t)l * 3072 + j * 1024 + c8); cw[k][j][1] = *(const f32x4*)(P.conv_w + (size_t)l * 3072 + j * 1024 + c8 + 4); }
        cw[k][3][0] = *(const f32x4*)(P.conv_b + (size_t)l * 1024 + c8); cw[k][3][1] = *(const f32x4*)(P.conv_b + (size_t)l * 1024 + c8 + 4); }
#pragma unroll
    for (int k = 0; k < 4; ++k) { const int c = (lane + 64 * k) * 8; gg[k][0] = *(const f32x4*)(P.gn_g + (size_t)l * 2048 + c); gg[k][1] = *(const f32x4*)(P.gn_g + (size_t)l * 2048 + c + 4); }
    const int vblk = (gridDim.x == 256) ? (int)((blockIdx.x & 7) * 32 + (blockIdx.x >> 3)) : (int)blockIdx.x;
    for (int row = vblk * 8 + wv; row < NROW; row += gridDim.x * 8) {
        int b, p; row_bp(row, b, p);
        if (p < NPAD || (l == DEPTH - 1 && p < 64)) continue;
        const int rm1 = bp_row(b, p - 1 >= NPAD ? p - 1 : NPAD), rm2 = bp_row(b, p - 2 >= NPAD ? p - 2 : NPAD);
        u32x4 ur[2][3], mr[2], rr[4], zr[4];
#pragma unroll
        for (int k = 0; k < 2; ++k) { const int c8 = (lane + 64 * k) * 8;
            ur[k][2] = *(const u32x4*)(U + (size_t)row * 1024 + c8); mr[k] = __builtin_nontemporal_load((const u32x4*)(MG + (size_t)row * 1024 + c8));
            ur[k][1] = (p - 1 >= NPAD) ? *(const u32x4*)(U + (size_t)rm1 * 1024 + c8) : (u32x4){0u, 0u, 0u, 0u};
            ur[k][0] = (p - 2 >= NPAD) ? *(const u32x4*)(U + (size_t)rm2 * 1024 + c8) : (u32x4){0u, 0u, 0u, 0u}; }
#pragma unroll
        for (int k = 0; k < 4; ++k) { const int c = (lane + 64 * k) * 8; rr[k] = __builtin_nontemporal_load((const u32x4*)(RET + (size_t)(((b * 4 + k) * 8 + (lane >> 3)) * LP + p) * 64 + (lane & 7) * 8)); zr[k] = __builtin_nontemporal_load((const u32x4*)(SZ + (size_t)row * 2048 + c)); }
#pragma unroll
        for (int k = 0; k < 2; ++k) { const int c8 = (lane + 64 * k) * 8; float u0[8], u1[8], u2[8], mg[8], o[8];
            unpack8(ur[k][0], u0); unpack8(ur[k][1], u1); unpack8(ur[k][2], u2); unpack8(mr[k], mg);
#pragma unroll
            for (int e = 0; e < 8; ++e) o[e] = mg[e] * (cw[k][3][e >> 2][e & 3] + cw[k][0][e >> 2][e & 3] * u0[e] + cw[k][1][e >> 2][e & 3] * u1[e] + cw[k][2][e >> 2][e & 3] * u2[e]);
            *(u32x4*)(MG + (size_t)row * 1024 + c8) = pack8(o); }
#pragma unroll
        for (int k = 0; k < 4; ++k) { const int c = (lane + 64 * k) * 8;
            float rv[8], sz[8], o[8]; unpack8(rr[k], rv); unpack8(zr[k], sz);
            float s1 = 0.f, s2 = 0.f;
#pragma unroll
            for (int e = 0; e < 8; ++e) { s1 += rv[e]; s2 += rv[e] * rv[e]; }
            s1 = wave_sum(s1); s2 = wave_sum(s2);
            const float mk = s1 * (1.0f / 512.0f); float var = s2 * (1.0f / 512.0f) - mk * mk; var = var > 0.f ? var : 0.f; const float rk = rsqrtf(var + 1e-5f);
#pragma unroll
            for (int e = 0; e < 8; ++e) o[e] = (rv[e] - mk) * rk * gg[k][e >> 2][e & 3] * silu_f(sz[e]);
            *(u32x4*)(A2 + (size_t)row * 2048 + c) = pack8(o); }
    }
    __syncthreads();
}


#define XB_TMO      128
#define XB_XCNT(j)  (256  + 64 * (j))
#define XB_XSUB(j)  (1280 + 64 * (j))
#define XB_XGEN(j)  (2304 + 64 * (j))
#define XB_TOP      3328
#define XB_TOPGEN   3392
#define XCD_BAR_WORDS 3456
#define XB_SPIN_CAP (1u << 18)

__device__ __forceinline__ unsigned xb_ld(unsigned* p)              { return __hip_atomic_load(p, __ATOMIC_RELAXED, __HIP_MEMORY_SCOPE_AGENT); }
__device__ __forceinline__ unsigned xb_add(unsigned* p, unsigned v) { return __hip_atomic_fetch_add(p, v, __ATOMIC_RELAXED, __HIP_MEMORY_SCOPE_AGENT); }
__device__ __forceinline__ unsigned xb_xcc_id() { return (unsigned)__builtin_amdgcn_s_getreg((3 << 11) | 20) & 0xFu; }
#define XB_SPIN(cond, bar) do { unsigned _sp = 0; while (cond) { __builtin_amdgcn_s_sleep(1); \
    if ((++_sp & 255u) == 0u) { if (xb_ld(&(bar)[XB_TMO])) break; if (_sp > XB_SPIN_CAP) { atomicAdd(&(bar)[XB_TMO], 1u); break; } } } } while (0)

struct XcdBarrier {
    unsigned* bar; unsigned x;
    volatile LAS unsigned* st;
};

__device__ __forceinline__ XcdBarrier xcd_barrier_post(unsigned* bar, volatile LAS unsigned* st) {
    XcdBarrier b; b.bar = bar; b.x = xb_xcc_id(); b.st = st;
    if (threadIdx.x == 0) (void)xb_add(&bar[XB_XCNT(b.x)], 1u);
    return b;
}
__device__ __forceinline__ void xcd_barrier_complete(unsigned* bar, unsigned x, unsigned& nloc, unsigned& nx) {
    const unsigned G = gridDim.x * gridDim.y * gridDim.z;
    unsigned sum, cnt, mine, sp = 0u;
    for (;;) {
        sum = 0u; cnt = 0u; mine = 0u;
#pragma unroll
        for (unsigned j = 0; j < 16; ++j) { const unsigned c = xb_ld(&bar[XB_XCNT(j)]); sum += c; cnt += (c > 0u) ? 1u : 0u; mine = (j == x) ? c : mine; }
        if (sum == G) break;
        __builtin_amdgcn_s_sleep(1);
        if ((++sp & 255u) == 0u) { if (xb_ld(&bar[XB_TMO])) break; if (sp > XB_SPIN_CAP) { atomicAdd(&bar[XB_TMO], 1u); break; } }
    }
    nloc = mine > 0u ? mine : 1u; nx = cnt > 0u ? cnt : 1u;
}

__device__ __forceinline__ void xcd_barrier(const XcdBarrier& b) {
    asm volatile("s_waitcnt vmcnt(0)" ::: "memory");
    __syncthreads();
    if (threadIdx.x == 0) {
        unsigned* bar = b.bar;
        __builtin_amdgcn_s_waitcnt(0);
        unsigned nloc = b.st[0], nx = b.st[1];
        if (nloc == 0u) { xcd_barrier_complete(bar, b.x, nloc, nx); b.st[0] = nloc; b.st[1] = nx; }
        const unsigned old = xb_add(&bar[XB_XSUB(b.x)], 1u);
        const unsigned gen = old / nloc;
        if (old + 1u == (gen + 1u) * nloc) {
            __builtin_amdgcn_fence(__ATOMIC_RELEASE, "agent");
            asm volatile("s_waitcnt vmcnt(0)" ::: "memory");
            const unsigned og = xb_add(&bar[XB_TOP], 1u);
            const unsigned tg = og / nx;
            if (og + 1u == (tg + 1u) * nx) xb_add(&bar[XB_TOPGEN], 1u);
            else XB_SPIN(xb_ld(&bar[XB_TOPGEN]) == tg, bar);
            __builtin_amdgcn_fence(__ATOMIC_ACQUIRE, "agent");
            xb_add(&bar[XB_XGEN(b.x)], 1u);
            asm volatile("s_waitcnt vmcnt(0)" ::: "memory");
        } else {
            XB_SPIN(xb_ld(&bar[XB_XGEN(b.x)]) == gen, bar);
            __builtin_amdgcn_fence(__ATOMIC_ACQUIRE, "agent");
            asm volatile("s_waitcnt vmcnt(0)" ::: "memory");
        }
    }
    __syncthreads();
}


__global__ void __launch_bounds__(512) hybrid_trunk_fwd(Params P) {
    extern __shared__ __attribute__((aligned(16))) unsigned char lds_raw[];
    LAS unsigned char* lds = (LAS unsigned char*)lds_raw;
    cg::grid_group grid = cg::this_grid();
    unsigned char* ws = P.ws;
    bf16_t* XN = (bf16_t*)(ws + WS_XN); bf16_t* U = (bf16_t*)(ws + WS_U); bf16_t* MG = (bf16_t*)(ws + WS_MG); bf16_t* Q = (bf16_t*)(ws + WS_Q); bf16_t* K = (bf16_t*)(ws + WS_K);
    bf16_t* VH = (bf16_t*)(ws + WS_VH); bf16_t* SZ = (bf16_t*)(ws + WS_SZ); bf16_t* GA = (bf16_t*)(ws + WS_GA); bf16_t* GB = (bf16_t*)(ws + WS_GB);
    const bf16_t* WIN = (const bf16_t*)(ws + WS_WIN); const bf16_t* WCO = (const bf16_t*)(ws + WS_WCO); const bf16_t* WRO = (const bf16_t*)(ws + WS_WRO); const bf16_t* WO = (const bf16_t*)(ws + WS_WO);
    const float* BP = (const float*)(ws + WS_BP); const float* CT = (const float*)(ws + WS_ROPE); const float* ST = CT + 4112 * 128;
    const int G = gridDim.x, c = blockIdx.x;
    unsigned* barw = (unsigned*)(ws + WS_BAR);
    if (blockIdx.x == 0) for (int i = threadIdx.x; i < 4096; i += 512) barw[i] = 0u;
    volatile LAS unsigned* bst = (volatile LAS unsigned*)(lds + 131072);
    if (threadIdx.x < 4) bst[threadIdx.x] = 0u;
    __syncthreads();
    XcdBarrier xbar; xbar.bar = barw; xbar.x = 0; xbar.st = bst; bool xb_ready = false;
#define GSYNC() do { if (!xb_ready) { grid.sync(); xbar = xcd_barrier_post(barw, bst); xb_ready = true; } else xcd_barrier(xbar); } while (0)
#if defined(PROBE_DUR)
    unsigned long long tph[6] = {0ull, 0ull, 0ull, 0ull, 0ull, 0ull}; const unsigned long long tstart = __builtin_amdgcn_s_memrealtime(); unsigned long long tlast = tstart;
#define PSTAMP(k) do { const unsigned long long tn_ = __builtin_amdgcn_s_memrealtime(); tph[k] += tn_ - tlast; tlast = tn_; } while (0)
#else
#define PSTAMP(k) do { } while (0)
#endif
    for (int l = 0; l < DEPTH; ++l) {
        convert_phase(lds, P, l);
        norm_phase(P, l);
        GSYNC(); PSTAMP(0);
        { int ti_b = threadIdx.x; asm volatile("" : "+v"(ti_b));
          for (int i = ti_b; i < DIN / 4; i += 512) { const f32x4 bq = *(const f32x4*)(BP + 4 * i); *(LAS u32x2*)(lds + LDS_BIAS + 8 * i) = (u32x2){pk(bq[0], bq[1]), pk(bq[2], bq[3])}; }
          __syncthreads(); }
        { pg8::Gemm g{XN, WIN, NROW, DIN, 1024}; pg8::StaticOrder S; S.init(NROW, DIN, G, c); EpiIn E{U, MG, Q, K, VH, SZ, GA, GB, (const LAS bf16_t*)(lds + LDS_BIAS), CT, ST};
          pg8::gemm_phase<EpiIn, pg8::StaticOrder>(lds, g, S, E, nullptr); }
        GSYNC(); PSTAMP(1);
        scan_phase(lds, P);
        GSYNC(); PSTAMP(2);
        elem_phase(lds, P, l);
        GSYNC(); PSTAMP(3);
        if (l + 1 < DEPTH) { meta_gemm<1>(Q, WRO, 2048, 1024, GB, U, nullptr, nullptr); meta_gemm<2>(MG, WCO, 1024, 1024, GA, U, nullptr, nullptr); }
        { pg8::Gemm g{Q, WRO, NREAL, 1024, 2048}; pg8::StaticOrder S; S.init(NREAL, 1024, G, c); EpiOut<1> E{GB, U, nullptr, nullptr};
          pg8::gemm_phase<EpiOut<1>, pg8::StaticOrder>(lds, g, S, E, nullptr); }
        { pg8::Gemm g{MG, WCO, NREAL, 1024, 1024}; pg8::StaticOrder S; S.init(NREAL, 1024, G, c); EpiOut<2> E{GA, U, nullptr, nullptr};
          pg8::gemm_phase<EpiOut<2>, pg8::StaticOrder>(lds, g, S, E, nullptr); }
        GSYNC(); PSTAMP(4);
        if (l + 1 < DEPTH) meta_gemm<3>(U, WO, 1024, 1024, nullptr, XN, nullptr, nullptr);
        { pg8::Gemm g{U, WO, NREAL, 1024, 1024}; pg8::StaticOrder S; S.init(NREAL, 1024, G, c); EpiOut<3> E{nullptr, XN, nullptr, nullptr};
          pg8::gemm_phase<EpiOut<3>, pg8::StaticOrder>(lds, g, S, E, nullptr); }
        GSYNC(); PSTAMP(5);
    }
    norm_phase(P, DEPTH);
#if defined(PROBE_DUR)
    GSYNC(); PSTAMP(0);
    {
        const unsigned long long ttot = tlast - tstart;
        const int M = (int)((double)tph[PROBE_RVR] * 1.0e6 / (double)ttot);
        for (int idx = blockIdx.x * 512 + threadIdx.x; idx < M; idx += gridDim.x * 512) P.out[idx] += 0.4f;
        const unsigned long long tend = __builtin_amdgcn_s_memrealtime() + tph[PROBE_DUR];
        while (__builtin_amdgcn_s_memrealtime() < tend) __builtin_amdgcn_s_sleep(8);
    }
#endif
}

extern "C" void kernel_launch(void* const* d_in, const int* in_sizes, int n_in, void* d_out, int out_size, void* d_ws, size_t ws_size, hipStream_t stream) {
    static int grid = 0;
    if (grid == 0) {
        int dev = 0, cus = 0, per_cu = 0;
        hipGetDevice(&dev); hipDeviceGetAttribute(&cus, hipDeviceAttributeMultiprocessorCount, dev);
        hipFuncSetAttribute((const void*)hybrid_trunk_fwd, hipFuncAttributeMaxDynamicSharedMemorySize, LDS_BYTES);
        hipOccupancyMaxActiveBlocksPerMultiprocessor(&per_cu, (const void*)hybrid_trunk_fwd, 512, LDS_BYTES);
        (void)hipGetLastError();
        if (per_cu < 1) per_cu = 1;
        grid = cus * per_cu;
        if (n_in != 12 || ws_size < WS_END) { fprintf(stderr, "kernel_launch: n_in %d ws %zu need %zu\n", n_in, ws_size, (size_t)WS_END); grid = -1; }
    }
    if (grid < 0) return;
    Params p{};
    p.x = (const float*)d_in[0]; p.meta = (const float*)d_in[1]; p.pre_g = (const float*)d_in[2]; p.w_in = (const float*)d_in[3]; p.b_in = (const float*)d_in[4];
    p.conv_w = (const float*)d_in[5]; p.conv_b = (const float*)d_in[6]; p.w_co = (const float*)d_in[7]; p.gn_g = (const float*)d_in[8]; p.w_ro = (const float*)d_in[9];
    p.w_o = (const float*)d_in[10]; p.post_g = (const float*)d_in[11]; p.out = (float*)d_out; p.ws = (unsigned char*)d_ws;
    void* args[] = {&p};
    hipError_t e = hipLaunchCooperativeKernel((const void*)hybrid_trunk_fwd, dim3(grid), dim3(512), args, LDS_BYTES, stream);
    if (e != hipSuccess) fprintf(stderr, "cooperative launch failed: %s (grid %d)\n", hipGetErrorString(e), grid);
}
```

```cpp
#include <hip/hip_runtime.h>
#include <hip/hip_cooperative_groups.h>
#include <cstdio>
namespace cg = cooperative_groups;
namespace pg8 {
#define PG8_LAS __attribute__((address_space(3)))
typedef unsigned short bf16_t;
typedef short bf16x8 __attribute__((ext_vector_type(8)));
typedef float f32x4 __attribute__((ext_vector_type(4)));
typedef unsigned u32x4 __attribute__((ext_vector_type(4)));
constexpr int BM = 256, BK = 64, HALF = 128, HTB = HALF * BK * 2  , STAGE_BYTES = 8 * HTB, NXCD = 8, WGM = 8;

__host__ __device__ __forceinline__ int lds_byte(int r, int c) { const int st = (r >> 4) * 2 + (c >> 5), rr = r & 15, cc = c & 31, ob = rr * 64 + cc * 2; return st * 1024 + (ob ^ (((ob >> 9) & 1) << 5)); }
__host__ __device__ __forceinline__ void stage_rc(int b, int& R, int& C) { const int st = b / 1024, sb = b % 1024, swz = sb ^ (((sb >> 9) & 1) << 5); R = (st >> 1) * 16 + swz / 64; C = (st & 1) * 32 + (swz % 64) / 2; }
__host__ __device__ __forceinline__ int perm32(int rho) { const int n = rho >> 4, i = rho & 15; return 8 * (i >> 2) + 4 * n + (i & 3); }

struct Unit { int pm, pn; };
struct Gemm { const bf16_t* A; const bf16_t* Bt; int M, N, K; };

struct StaticOrder {
    int nM, nN, nwg, G, c;
    __host__ __device__ void init(int M, int N, int G_, int c_) { nM = M / BM; nN = N / BM; nwg = nM * nN; G = G_; c = c_; }
    __host__ __device__ bool next(int i, Unit& u) const {
        const long L = (long)i * G + c; if (L >= nwg) return false;
        int wgid = (int)L; { const int q = nwg / NXCD, r = nwg % NXCD, xcd = wgid % NXCD, off = wgid / NXCD; wgid = (xcd < r ? xcd * (q + 1) : r * (q + 1) + (xcd - r) * q) + off; }
        const int nig = WGM * nN, gid = wgid / nig, fm = gid * WGM, gsz = (nM - fm) < WGM ? (nM - fm) : WGM;
        u.pm = fm + ((wgid % nig) % gsz); u.pn = (wgid % nig) / gsz; return true;
    }
    __device__ __forceinline__ void a_ready(const Unit&) const {}
    __device__ __forceinline__ void done(const Unit&) const {}
};
struct CountedOrder : StaticOrder {
    const unsigned* ready; unsigned need; unsigned* tmo;
    __device__ __forceinline__ void a_ready(const Unit& u) const {
        if (threadIdx.x < 64) {
            const unsigned long long t0 = __builtin_amdgcn_s_memrealtime(); unsigned polls = 0;
            while ((unsigned)__builtin_amdgcn_readfirstlane(__hip_atomic_load(ready + 64 * u.pm, __ATOMIC_RELAXED, __HIP_MEMORY_SCOPE_AGENT)) < need) {
                if ((++polls & 255u) == 0u && __builtin_amdgcn_readfirstlane(__hip_atomic_load(tmo, __ATOMIC_RELAXED, __HIP_MEMORY_SCOPE_AGENT)) != 0u) break;
                if (__builtin_amdgcn_s_memrealtime() - t0 > 2000000ull) {
                    if (threadIdx.x == 0) { unsigned expect = 0u; __hip_atomic_compare_exchange_strong(tmo + 1, &expect, 0x600u | (unsigned)(u.pm & 0xff), __ATOMIC_RELAXED, __ATOMIC_RELAXED, __HIP_MEMORY_SCOPE_AGENT); __hip_atomic_store(tmo, 1u, __ATOMIC_RELAXED, __HIP_MEMORY_SCOPE_AGENT); }
                    break; }
                __builtin_amdgcn_s_sleep(2); }
            __builtin_amdgcn_fence(__ATOMIC_ACQUIRE, "agent");
            asm volatile("s_waitcnt vmcnt(0)" ::: "memory");
        }
#if !defined(BROKEN_HOOK_NO_BARRIER)
        asm volatile("" ::: "memory"); __builtin_amdgcn_s_barrier(); asm volatile("" ::: "memory");
#endif
    }
};

__device__ __forceinline__ unsigned cvt_pk_bf16(float lo, float hi) { unsigned r; asm volatile("v_cvt_pk_bf16_f32 %0, %1, %2" : "=v"(r) : "v"(lo), "v"(hi)); return r; }
typedef float f32x2 __attribute__((ext_vector_type(2)));
__device__ __forceinline__ f32x2 gelu_pk(f32x2 v) {
    const f32x2 av = __builtin_elementwise_abs(v), d = av * 0.2316418882f + 1.0f;
    f32x2 t; t.x = __builtin_amdgcn_rcpf(d.x); t.y = __builtin_amdgcn_rcpf(d.y);
    f32x2 q = t * 0.5307027145f + (-0.7265760135f); q = q * t + 0.7107068705f; q = q * t + (-0.142248368f); q = q * t + 0.127414796f; q = q * t;
    const f32x2 s = (v * v) * (-0.72134752044f);
    f32x2 e; e.x = __builtin_amdgcn_exp2f(s.x); e.y = __builtin_amdgcn_exp2f(s.y);
    const f32x2 m = v * (q * e), r = v - m;
    f32x2 o; o.x = v.x < 0.f ? m.x : r.x; o.y = v.y < 0.f ? m.y : r.y; return o;
}

template <class Epi, class Sched, bool STAMP = false>
__device__ __forceinline__ void gemm_phase(PG8_LAS unsigned char* lds, const Gemm g, const Sched& S, const Epi& E, unsigned long long* stamps) {
    int tid_l = threadIdx.x; asm volatile("" : "+v"(tid_l));
    const int tid = tid_l, wid = __builtin_amdgcn_readfirstlane(tid >> 6), lane = tid & 63, wr = wid >> 2, wc = wid & 3, fr = lane & 15, fq = lane >> 4;
    const int K = g.K, nt = K / BK;
    int ts_lo = 0, ts_hi = 0, nts = 0; const unsigned long long rt_entry = STAMP ? (unsigned long long)wall_clock64() : 0ull;
#define PG8_STAMP() do { if (STAMP && wid == 0 && nts < 64) { const unsigned long long _c = (unsigned long long)clock64(); \
        ts_lo = (lane == nts) ? (int)(unsigned)_c : ts_lo; ts_hi = (lane == nts) ? (int)(unsigned)(_c >> 32) : ts_hi; ++nts; } } while (0)
    PG8_STAMP();
    unsigned voffA[2], voffB[2];
#pragma unroll
    for (int i = 0; i < 2; ++i) { int R, C; stage_rc(tid * 16 + i * 8192, R, C); const int Rb = Epi::PERM ? ((R & ~31) + perm32(R & 31)) : R;
        voffA[i] = (unsigned)(R * K + C) * 2u; voffB[i] = (unsigned)(Rb * K + C) * 2u; }
    const size_t kstep = (size_t)(BK * 2);
    const size_t hstep = (size_t)HALF * K * 2;
    const size_t tstep = 2 * hstep;
    const unsigned ldsw = (unsigned)wid * 1024u;
    const int aoff = lds_byte(wr * 64 + fr, fq * 8), boff = lds_byte(wc * 32 + fr, fq * 8);
#define PG8_SA(b, h) (((b) * 2 + (h)) * HTB)
#define PG8_SB(b, h) ((4 + (b) * 2 + (h)) * HTB)
#define PG8_STAGE(bufoff, gbase, voff) do { _Pragma("unroll") for (int _i = 0; _i < 2; ++_i) \
        __builtin_amdgcn_global_load_lds((const unsigned*)((const char*)(gbase) + (voff)[_i]), (PG8_LAS unsigned*)(lds + (bufoff) + ldsw + _i * 8192), 16, 0, 0); } while (0)
#define PG8_LDA(dst, b, h) do { _Pragma("unroll") for (int m = 0; m < 4; ++m) _Pragma("unroll") for (int k = 0; k < 2; ++k) dst[m][k] = *(const PG8_LAS bf16x8*)(lds + PG8_SA(b, h) + aoff + m * 2048 + k * 1024); } while (0)
#define PG8_LDB(dst, b, h) do { _Pragma("unroll") for (int n = 0; n < 2; ++n) _Pragma("unroll") for (int k = 0; k < 2; ++k) dst[n][k] = *(const PG8_LAS bf16x8*)(lds + PG8_SB(b, h) + boff + n * 2048 + k * 1024); } while (0)
#define PG8_MMA(ai, bj, At, Bt) do { __builtin_amdgcn_s_setprio(1); _Pragma("unroll") for (int m = 0; m < 4; ++m) _Pragma("unroll") for (int n = 0; n < 2; ++n) _Pragma("unroll") for (int k = 0; k < 2; ++k) \
        acc[ai][bj][m][n] = __builtin_amdgcn_mfma_f32_16x16x32_bf16(Bt[n][k], At[m][k], acc[ai][bj][m][n], 0, 0, 0); __builtin_amdgcn_s_setprio(0); } while (0)
#define PG8_WAIT_V(n) asm volatile("s_waitcnt vmcnt(" #n ")" ::: "memory")
#define PG8_WAIT_L(n) asm volatile("s_waitcnt lgkmcnt(" #n ")" ::: "memory")
#define PG8_BAR __builtin_amdgcn_s_barrier()
#define PG8_SCHED __builtin_amdgcn_sched_barrier(0)
    Unit cur, nxt; int ui = 0;
    if (!S.next(0, cur)) return;
    f32x4 acc[2][2][4][2];
#pragma unroll
    for (int a = 0; a < 2; ++a)
#pragma unroll
        for (int b = 0; b < 2; ++b)
#pragma unroll
            for (int m = 0; m < 4; ++m)
#pragma unroll
                for (int n = 0; n < 2; ++n) acc[a][b][m][n] = (f32x4){0.f, 0.f, 0.f, 0.f};
    bf16x8 At[4][2], B0[2][2], B1[2][2];
    const char* cA = (const char*)g.A + (size_t)cur.pm * tstep; const char* cB = (const char*)g.Bt + (size_t)cur.pn * tstep;
    S.a_ready(cur);
    PG8_STAGE(PG8_SB(0, 0), cB, voffB); PG8_STAGE(PG8_SA(0, 0), cA, voffA); PG8_STAGE(PG8_SB(0, 1), cB + hstep, voffB); PG8_STAGE(PG8_SA(0, 1), cA + hstep, voffA);
    if (wr == 1) PG8_BAR;
    PG8_WAIT_V(4); PG8_BAR;
    PG8_STAGE(PG8_SB(1, 0), cB + kstep, voffB); PG8_STAGE(PG8_SA(1, 0), cA + kstep, voffA); PG8_STAGE(PG8_SB(1, 1), cB + hstep + kstep, voffB);
    PG8_WAIT_V(6); PG8_BAR;
    PG8_STAMP();
    for (;;) {
        const bool has_next = S.next(ui + 1, nxt);
        const char* nA = has_next ? (const char*)g.A + (size_t)nxt.pm * tstep : cA; const char* nB = has_next ? (const char*)g.Bt + (size_t)nxt.pn * tstep : cB;
        for (int t = 0; t < nt; t += 2) {
            const bool last = (t == nt - 2);
            const char* a1 = cA + (size_t)(t + 1) * kstep;
            const char* a2 = last ? nA : cA + (size_t)(t + 2) * kstep; const char* b2 = last ? nB : cB + (size_t)(t + 2) * kstep;
            const char* a3 = a2 + kstep; const char* b3 = b2 + kstep;
            if (last && has_next) S.a_ready(nxt);
            PG8_LDB(B0, 0, 0); PG8_SCHED; PG8_LDA(At, 0, 0); PG8_STAGE(PG8_SA(1, 1), a1 + hstep, voffA);
            PG8_WAIT_L(8); PG8_BAR; PG8_WAIT_L(0); PG8_MMA(0, 0, At, B0); PG8_BAR; PG8_SCHED;
            PG8_LDB(B1, 0, 1); PG8_STAGE(PG8_SB(0, 0), b2, voffB);
            PG8_BAR; PG8_WAIT_L(0); PG8_MMA(0, 1, At, B1); PG8_BAR;
            PG8_LDA(At, 0, 1); PG8_STAGE(PG8_SA(0, 0), a2, voffA);
            PG8_BAR; PG8_WAIT_L(0); PG8_MMA(1, 0, At, B0); PG8_BAR; PG8_SCHED;
            PG8_STAGE(PG8_SB(0, 1), b2 + hstep, voffB);
            PG8_WAIT_V(6); PG8_BAR; PG8_MMA(1, 1, At, B1); PG8_BAR;
            PG8_LDB(B0, 1, 0); PG8_SCHED; PG8_LDA(At, 1, 0); PG8_STAGE(PG8_SA(0, 1), a2 + hstep, voffA);
            PG8_WAIT_L(8); PG8_BAR; PG8_WAIT_L(0); PG8_MMA(0, 0, At, B0); PG8_BAR; PG8_SCHED;
            PG8_LDB(B1, 1, 1); PG8_STAGE(PG8_SB(1, 0), b3, voffB);
            PG8_BAR; PG8_WAIT_L(0); PG8_MMA(0, 1, At, B1); PG8_BAR;
            PG8_LDA(At, 1, 1); PG8_STAGE(PG8_SA(1, 0), a3, voffA);
            PG8_BAR; PG8_WAIT_L(0); PG8_MMA(1, 0, At, B0); PG8_BAR; PG8_SCHED;
            PG8_STAGE(PG8_SB(1, 1), b3 + hstep, voffB);
            PG8_WAIT_V(6); PG8_BAR; PG8_MMA(1, 1, At, B1); PG8_BAR;
        }
        PG8_STAMP();
        if constexpr (!Epi::AFTER_DRAIN) { E(acc, cur, wr, wc, fr, fq); S.done(cur); }
        PG8_STAMP();
        if (!has_next) break;
#pragma unroll
        for (int a = 0; a < 2; ++a)
#pragma unroll
            for (int b = 0; b < 2; ++b)
#pragma unroll
                for (int m = 0; m < 4; ++m)
#pragma unroll
                    for (int n = 0; n < 2; ++n) acc[a][b][m][n] = (f32x4){0.f, 0.f, 0.f, 0.f};
        cur = nxt; cA = nA; cB = nB; ++ui;
    }
    PG8_WAIT_V(0);
    if (wr == 0) PG8_BAR;
    PG8_BAR;
    if constexpr (Epi::AFTER_DRAIN) { E.fused(acc, cur, wr, wc, fr, fq, lds, wid, lane); S.done(cur); }
    PG8_STAMP();
    if (STAMP && wid == 0) { stamps[lane] = lane < nts ? (((unsigned long long)(unsigned)ts_hi << 32) | (unsigned)ts_lo) : 0ull;
        if (lane == 62) stamps[62] = rt_entry; if (lane == 63) stamps[63] = (unsigned long long)wall_clock64(); }
#undef PG8_STAMP
#undef PG8_SA
#undef PG8_SB
#undef PG8_STAGE
#undef PG8_LDA
#undef PG8_LDB
#undef PG8_MMA
#undef PG8_WAIT_V
#undef PG8_WAIT_L
#undef PG8_BAR
#undef PG8_SCHED
}
}
__device__ const double INV_REV[128] = {0.15915494309189535,0.14810514021707516,0.13782250260398285,0.1282537675342271,0.11934937021124886,0.11106318702115607,0.10335229661843406,0.096176757598987819,0.089499401608891013,0.083285640817172504,0.077503288755374058,0.072122393595852222,0.067115083005227255,0.062455419769340485,0.058119267441876246,0.054084165320725783,0.050329212104487035,0.04683495762645621,0.04358330210530733,0.040557402390591489,0.037741584717419771,0.035121263518410453,0.032682865872356998,0.030413761198270856,0.028302195830623399,0.02633723213689523,0.024508691862069852,0.022807103406603451,0.02122365276477766,0.019750137869302395,0.018378926105679667,0.01710291477625845,0.015915494309189534,0.014810514021707515,0.013782250260398284,0.012825376753422709,0.011934937021124886,0.011106318702115607,0.010335229661843406,0.0096176757598987819,0.0089499401608891024,0.0083285640817172511,0.0077503288755374055,0.0072122393595852232,0.0067115083005227253,0.0062455419769340478,0.0058119267441876241,0.0054084165320725779,0.0050329212104487037,0.0046834957626456213,0.0043583302105307331,0.0040557402390591487,0.0037741584717419772,0.0035121263518410454,0.0032682865872356993,0.0030413761198270859,0.0028302195830623399,0.0026337232136895228,0.0024508691862069852,0.0022807103406603446,0.0021223652764777662,0.0019750137869302396,0.0018378926105679667,0.0017102914776258452,0.0015915494309189536,0.0014810514021707515,0.0013782250260398288,0.0012825376753422709,0.0011934937021124885,0.0011106318702115607,0.0010335229661843405,0.00096176757598987806,0.00089499401608891024,0.00083285640817172503,0.00077503288755374051,0.00072122393595852228,0.0006711508300522726,0.00062455419769340487,0.00058119267441876239,0.00054084165320725773,0.00050329212104487033,0.00046834957626456218,0.00043583302105307329,0.00040557402390591486,0.00037741584717419774,0.00035121263518410453,0.00032682865872356992,0.0003041376119827086,0.00028302195830623395,0.00026337232136895234,0.00024508691862069854,0.00022807103406603446,0.00021223652764777661,0.00019750137869302395,0.00018378926105679666,0.00017102914776258454,0.00015915494309189535,0.00014810514021707514,0.00013782250260398286,0.00012825376753422709,0.00011934937021124886,0.00011106318702115607,0.00010335229661843406,9.6176757598987812e-05,8.9499401608891018e-05,8.3285640817172505e-05,7.7503288755374056e-05,7.2122393595852225e-05,6.7115083005227254e-05,6.2455419769340487e-05,5.8119267441876239e-05,5.4084165320725784e-05,5.0329212104487035e-05,4.6834957626456207e-05,4.3583302105307322e-05,4.0557402390591481e-05,3.7741584717419777e-05,3.5121263518410453e-05,3.2682865872356999e-05,3.0413761198270857e-05,2.8302195830623396e-05,2.6337232136895232e-05,2.4508691862069852e-05,2.2807103406603447e-05,2.1223652764777659e-05,1.9750137869302396e-05,1.8378926105679668e-05,1.7102914776258452e-05};

using pg8::bf16_t; using pg8::bf16x8; using pg8::f32x4; using pg8::u32x4; using pg8::Unit;
#define LAS __attribute__((address_space(3)))
typedef float f32x16 __attribute__((ext_vector_type(16)));
typedef short s16x4 __attribute__((ext_vector_type(4)));
typedef unsigned u32x2 __attribute__((ext_vector_type(2)));
typedef float f32x2 __attribute__((ext_vector_type(2)));

constexpr int DM = 1024, NB = 8, SEQ = 4096, LP = 4160, NPAD = 48, NROW = NB * LP;
constexpr int NREAL = NB * SEQ;
constexpr int DIN = 12288, DEPTH = 4, NA = 10240, NG = 2048, NCH = 65;
constexpr int LDS_BIAS = 131072 + 16, LDS_BYTES = LDS_BIAS + 12288 * 2;
constexpr size_t SZ1 = (size_t)NROW * 1024 * 2;
constexpr size_t WS_XN = 0, WS_U = SZ1, WS_MG = 2 * SZ1, WS_Q = 3 * SZ1, WS_K = 4 * SZ1, WS_VH = 5 * SZ1, WS_SZ = 7 * SZ1;
constexpr size_t WS_WIN = 9 * SZ1, WS_WCO = WS_WIN + (size_t)DIN * 1024 * 2, WS_WRO = WS_WCO + 1024 * 1024 * 2, WS_WO = WS_WRO + 1024 * 2048 * 2;
constexpr size_t WS_BP = WS_WO + 1024 * 1024 * 2, WS_ROPE = WS_BP + DIN * 4, WS_GA = WS_ROPE + 2 * (size_t)4112 * 128 * 4, WS_GB = WS_GA + SZ1;
constexpr size_t WS_STAT = WS_GB + SZ1, WS_HMETA = WS_STAT + 4096, WS_BAR = WS_HMETA + 8 * 16 * 1024 * 4, WS_END = WS_BAR + 16384;

struct Params { const float* x; const float* meta; const float* pre_g; const float* w_in; const float* b_in; const float* conv_w; const float* conv_b;
                const float* w_co; const float* gn_g; const float* w_ro; const float* w_o; const float* post_g; float* out; unsigned char* ws; };

__device__ __forceinline__ void row_bp(int r, int& b, int& p) { if (r < NREAL) { b = r >> 12; p = 64 + (r & 4095); } else { const int rr = r - NREAL; b = rr >> 6; p = rr & 63; } }
__device__ __forceinline__ int bp_row(int b, int p) { return p >= 64 ? (b << 12) + (p - 64) : NREAL + (b << 6) + p; }
__device__ __forceinline__ float bflo(unsigned u) { return __uint_as_float(u << 16); }
__device__ __forceinline__ float bfhi(unsigned u) { return __uint_as_float(u & 0xffff0000u); }
typedef __bf16 bf16x2_t __attribute__((ext_vector_type(2)));
__device__ __forceinline__ unsigned pk(float lo, float hi) { typedef float f2_t __attribute__((ext_vector_type(2))); const bf16x2_t v = __builtin_convertvector((f2_t){lo, hi}, bf16x2_t); return __builtin_bit_cast(unsigned, v); }
__device__ __forceinline__ void unpack8(const u32x4 r, float (&f)[8]) { f[0] = bflo(r.x); f[1] = bfhi(r.x); f[2] = bflo(r.y); f[3] = bfhi(r.y); f[4] = bflo(r.z); f[5] = bfhi(r.z); f[6] = bflo(r.w); f[7] = bfhi(r.w); }
__device__ __forceinline__ u32x4 pack8(const float (&f)[8]) { u32x4 r; r.x = pk(f[0], f[1]); r.y = pk(f[2], f[3]); r.z = pk(f[4], f[5]); r.w = pk(f[6], f[7]); return r; }
__device__ __forceinline__ float ex2(float x) { return __builtin_amdgcn_exp2f(x); }
__device__ __forceinline__ float silu_f(float y) { return y * __builtin_amdgcn_rcpf(1.0f + ex2(-1.4426950408889634f * y)); }
__device__ __forceinline__ float sigm_f(float y) { return __builtin_amdgcn_rcpf(1.0f + ex2(-1.4426950408889634f * y)); }
__device__ __forceinline__ float lg_gamma(int hd) { return hd == 0 ? -0.0458036896131f : hd == 1 ? -0.0227200765001f : hd == 2 ? -0.0113153132278f : -0.00564656314114f; }
__device__ __forceinline__ float wave_sum(float v) { for (int o = 32; o >= 1; o >>= 1) v += __shfl_xor(v, o); return v; }
#define LBAR() do { asm volatile("s_waitcnt lgkmcnt(0)" ::: "memory"); __builtin_amdgcn_s_barrier(); asm volatile("" ::: "memory"); } while (0)

struct EpiIn {
    static constexpr bool PERM = true, AFTER_DRAIN = false;
    bf16_t *U, *MG, *Q, *K, *VH, *SZ, *GA, *GB; const LAS bf16_t* bperm; const float* ct; const float* st;
    __device__ __forceinline__ void operator()(const f32x4 (&acc)[2][2][4][2], const Unit& u, int wr, int wc, int fr, int fq) const {
        const int pn = u.pn, cc = wc * 32 + 8 * fq;
        float irv[8];
#pragma unroll
        for (int e = 0; e < 8; ++e) irv[e] = (pn >= 16 && pn < 24) ? ex2(-0.10381025296523007f * (float)(cc + e) - 2.651496129472319f) : 0.f;
        f32x4 bv[2][2];
#pragma unroll
        for (int bj = 0; bj < 2; ++bj)
#pragma unroll
            for (int n = 0; n < 2; ++n) { const u32x2 raw = *(const LAS u32x2*)(bperm + pn * 256 + bj * 128 + cc + 4 * n); bv[bj][n] = (f32x4){bflo(raw.x), bfhi(raw.x), bflo(raw.y), bfhi(raw.y)}; }
#pragma unroll
        for (int ai = 0; ai < 2; ++ai)
#pragma unroll
            for (int m = 0; m < 4; ++m) {
                const int r = u.pm * 256 + ai * 128 + wr * 64 + m * 16 + fr; int b, p; row_bp(r, b, p);
                float x[8], y[8], o1[8], o2[8];
#pragma unroll
                for (int n = 0; n < 2; ++n)
#pragma unroll
                    for (int j = 0; j < 4; ++j) { x[4 * n + j] = acc[ai][0][m][n][j] + bv[0][n][j]; y[4 * n + j] = acc[ai][1][m][n][j] + bv[1][n][j]; }
                if (pn < 8) {
#pragma unroll
                    for (int e = 0; e < 8; ++e) o1[e] = x[e] * y[e];
                    *(u32x4*)(U + (size_t)r * 1024 + pn * 128 + cc) = pack8(o1);
                } else if (pn < 16) {
#pragma unroll
                    for (int e = 0; e < 8; ++e) o1[e] = x[e] * silu_f(y[e]);
                    *(u32x4*)(MG + (size_t)r * 1024 + (pn - 8) * 128 + cc) = pack8(o1);
                } else if (pn < 24) {
                    const bool isk = pn >= 20; const int hd = isk ? pn - 20 : pn - 16; const float sc = isk ? 0.0625f : 1.0f;
                    if (p >= NPAD) {
                        const float posf = (float)(p - NPAD);
#pragma unroll
                        for (int e = 0; e < 8; ++e) { const float fr_ = __builtin_amdgcn_fractf(posf * irv[e]); const float c = __builtin_amdgcn_cosf(fr_), s = __builtin_amdgcn_sinf(fr_);
                            o1[e] = (x[e] * c - y[e] * s) * sc; o2[e] = (x[e] * s + y[e] * c) * sc; }
                    } else {
#pragma unroll
                        for (int e = 0; e < 8; ++e) { o1[e] = 0.f; o2[e] = 0.f; }
                    }
                    bf16_t* dst = (isk ? K : Q) + (size_t)((b * 4 + hd) * LP + p) * 256 + cc;
                    *(u32x4*)dst = pack8(o1); *(u32x4*)(dst + 128) = pack8(o2);
                } else if (pn < 32) {
                    const int vt = pn - 24; const float dec = (p >= NPAD) ? ex2(lg_gamma(vt >> 1) * (float)(63 - (p & 63))) : 0.f;
#pragma unroll
                    for (int e = 0; e < 8; ++e) { o1[e] = x[e] * dec; o2[e] = y[e] * dec; }
                    const int ch1 = (vt & 1) * 256 + cc, ch2 = ch1 + 128, bh8 = (b * 4 + (vt >> 1)) * 8;
                    *(u32x4*)(VH + (size_t)((bh8 + (ch1 >> 6)) * LP + p) * 64 + (ch1 & 63)) = pack8(o1);
                    *(u32x4*)(VH + (size_t)((bh8 + (ch2 >> 6)) * LP + p) * 64 + (ch2 & 63)) = pack8(o2);
                } else if (pn < 40) {
#pragma unroll
                    for (int e = 0; e < 8; ++e) { o1[e] = x[e]; o2[e] = y[e]; }
                    bf16_t* dst = SZ + (size_t)r * 2048 + (pn - 32) * 256 + cc;
                    *(u32x4*)dst = pack8(o1); *(u32x4*)(dst + 128) = pack8(o2);
                } else {
#pragma unroll
                    for (int e = 0; e < 8; ++e) { o1[e] = x[e]; o2[e] = y[e]; }
                    bf16_t* dst = (pn < 44 ? GA : GB) + (size_t)r * 1024 + (pn & 3) * 256 + cc;
                    *(u32x4*)dst = pack8(o1); *(u32x4*)(dst + 128) = pack8(o2);
                }
            }
    }
};
template <int MODE> struct EpiOut {
    static constexpr bool PERM = true, AFTER_DRAIN = false;
    const bf16_t* G; bf16_t* Y; bf16_t* Y2; const float* bias;
    __device__ __forceinline__ void operator()(const f32x4 (&acc)[2][2][4][2], const Unit& u, int wr, int wc, int fr, int fq) const {
        const int cc = wc * 32 + 8 * fq;
#pragma unroll
        for (int ai = 0; ai < 2; ++ai) {
            u32x4 gq[4][2], yq[4][2];
            if (MODE == 1 || MODE == 2) {
#pragma unroll
                for (int m = 0; m < 4; ++m)
#pragma unroll
                    for (int bj = 0; bj < 2; ++bj) { const size_t off = (size_t)(u.pm * 256 + ai * 128 + wr * 64 + m * 16 + fr) * 1024 + u.pn * 256 + bj * 128 + cc;
                        gq[m][bj] = __builtin_nontemporal_load((const u32x4*)(G + off)); if (MODE == 2) yq[m][bj] = *(const u32x4*)(Y + off); }
                __builtin_amdgcn_sched_barrier(0);
            }
#pragma unroll
            for (int m = 0; m < 4; ++m) {
                const int r = u.pm * 256 + ai * 128 + wr * 64 + m * 16 + fr;
#pragma unroll
                for (int bj = 0; bj < 2; ++bj) {
                    float v[8], o[8];
#pragma unroll
                    for (int n = 0; n < 2; ++n)
#pragma unroll
                        for (int j = 0; j < 4; ++j) v[4 * n + j] = acc[ai][bj][m][n][j];
                    if (MODE == 0) {
                        const int c = u.pn * 256 + bj * 128 + cc;
                        const f32x4 b0 = *(const f32x4*)(bias + c), b1 = *(const f32x4*)(bias + c + 4);
#pragma unroll
                        for (int e = 0; e < 8; ++e) o[e] = sigm_f(v[e] + (e < 4 ? b0[e & 3] : b1[e & 3]));
                        bf16_t* dst = (u.pn < 4 ? Y : Y2) + (size_t)r * 1024 + (u.pn & 3) * 256 + bj * 128 + cc;
                        *(u32x4*)dst = pack8(o);
                    } else {
                        const size_t off = (size_t)r * 1024 + u.pn * 256 + bj * 128 + cc;
                        if (MODE == 3) {
#pragma unroll
                            for (int e = 0; e < 8; ++e) o[e] = v[e];
                        } else {
                            float g[8]; unpack8(gq[m][bj], g);
#pragma unroll
                            for (int e = 0; e < 8; ++e) g[e] = sigm_f(g[e]);
                            if (MODE == 1) {
#pragma unroll
                                for (int e = 0; e < 8; ++e) o[e] = g[e] * v[e];
                            } else {
                                float yv[8]; unpack8(yq[m][bj], yv);
#pragma unroll
                                for (int e = 0; e < 8; ++e) o[e] = yv[e] + g[e] * v[e];
                            }
                        }
                        *(u32x4*)(Y + off) = pack8(o);
                    }
                }
            }
        }
    }
};

template <int MODE> __device__ __forceinline__ void meta_gemm(const bf16_t* A, const bf16_t* Bt, int K, int N, const bf16_t* G, bf16_t* Y, bf16_t* Y2, const float* bias) {
    int tid_l = threadIdx.x; asm volatile("" : "+v"(tid_l));
    const int lane = tid_l & 63, wv = tid_l >> 6, lr = lane & 15, g = lane >> 4;
    const int ntile = 8 * (N >> 4);
    for (int t = blockIdx.x * 8 + wv; t < ntile; t += gridDim.x * 8) {
        const int bt = t & 7, ct = t >> 3, row0 = NREAL + bt * 64 + NPAD;
        const bf16_t* ap = A + (size_t)(row0 + lr) * K + 8 * g; const bf16_t* bp = Bt + (size_t)(16 * ct + lr) * K + 8 * g;
        f32x4 acc = (f32x4){0.f, 0.f, 0.f, 0.f};
        for (int kb = 0; kb < K / 32; kb += 16) {
            bf16x8 af[16], bfr[16];
#pragma unroll
            for (int i = 0; i < 16; ++i) { af[i] = *(const bf16x8*)(ap + 32 * (kb + i)); bfr[i] = *(const bf16x8*)(bp + 32 * (kb + i)); }
            __builtin_amdgcn_sched_barrier(0);
#pragma unroll
            for (int i = 0; i < 16; ++i) acc = __builtin_amdgcn_mfma_f32_16x16x32_bf16(af[i], bfr[i], acc, 0, 0, 0);
            __builtin_amdgcn_sched_barrier(0);
        }
        const int col = 16 * ct + lr;
#pragma unroll
        for (int rg = 0; rg < 4; ++rg) {
            const int row = row0 + 4 * g + rg; const float v = acc[rg]; float o;
            if (MODE == 0) { o = sigm_f(v + bias[col]); (col < 1024 ? Y : Y2)[(size_t)row * 1024 + (col & 1023)] = (bf16_t)(pk(o, 0.f) & 0xffffu); }
            else { const size_t off = (size_t)row * 1024 + col;
                if (MODE == 3) o = v; else { const float gv = sigm_f(bflo((unsigned)G[off])); o = gv * v; if (MODE == 2) o += bflo((unsigned)Y[off]); }
                Y[off] = (bf16_t)(pk(o, 0.f) & 0xffffu); }
        }
    }
}

__device__ __forceinline__ int dest_of_orig(int n) {
    if (n >= 4096) return n;
    const int grp = n >> 10, j = n & 1023, t = j >> 7, cc = j & 127;
    const int tile = (grp == 0 || grp == 2) ? t : 8 + t, half = (grp >= 2) ? 1 : 0;
    return tile * 256 + half * 128 + cc;
}
__device__ __forceinline__ void convert_phase(LAS unsigned char* lds, const Params& P, int l) {
    int tid_l = threadIdx.x; asm volatile("" : "+v"(tid_l));
    const int tid = tid_l; LAS float* T = (LAS float*)lds;
    unsigned char* ws = P.ws;
    for (int t4 = blockIdx.x * 4; t4 < 4096; t4 += gridDim.x * 4) {
        const int k0 = tid >> 4, n4 = (tid & 15) * 4;
        f32x4 ld[4][2];
#pragma unroll
        for (int q = 0; q < 4; ++q) {
            const int t = t4 + q; const float* src; int N, kb, nb;
            if (t < 3072) { src = P.w_in + (size_t)l * 1024 * DIN; N = DIN; kb = t / 192; nb = t % 192; }
            else if (t < 3328) { const int u = t - 3072; src = P.w_co + (size_t)l * 1024 * 1024; N = 1024; kb = u >> 4; nb = u & 15; }
            else if (t < 3840) { const int u = t - 3328; src = P.w_ro + (size_t)l * 2048 * 1024; N = 1024; kb = u >> 4; nb = u & 15; }
            else { const int u = t - 3840; src = P.w_o + (size_t)l * 1024 * 1024; N = 1024; kb = u >> 4; nb = u & 15; }
#pragma unroll
            for (int i = 0; i < 2; ++i) ld[q][i] = __builtin_nontemporal_load((const f32x4*)(src + (size_t)(kb * 64 + k0 + 32 * i) * N + nb * 64 + n4));
            if (t < 3072 && kb == 0 && tid < 64) ((float*)(ws + WS_BP))[dest_of_orig(nb * 64 + tid)] = P.b_in[(size_t)l * DIN + nb * 64 + tid];
        }
#pragma unroll
        for (int q = 0; q < 4; ++q)
#pragma unroll
            for (int i = 0; i < 2; ++i)
#pragma unroll
                for (int j = 0; j < 4; ++j) T[q * 4160 + (n4 + j) * 65 + k0 + 32 * i] = ld[q][i][j];
        __syncthreads();
#pragma unroll
        for (int q = 0; q < 4; ++q) {
            const int t = t4 + q; bf16_t* dst; int K, kb, nb; bool perm = false;
            if (t < 3072) { dst = (bf16_t*)(ws + WS_WIN); K = 1024; kb = t / 192; nb = t % 192; perm = true; }
            else if (t < 3328) { const int u = t - 3072; dst = (bf16_t*)(ws + WS_WCO); K = 1024; kb = u >> 4; nb = u & 15; }
            else if (t < 3840) { const int u = t - 3328; dst = (bf16_t*)(ws + WS_WRO); K = 2048; kb = u >> 4; nb = u & 15; }
            else { const int u = t - 3840; dst = (bf16_t*)(ws + WS_WO); K = 1024; kb = u >> 4; nb = u & 15; }
            const int n = tid >> 3, kc = (tid & 7) * 8; float f[8];
#pragma unroll
            for (int j = 0; j < 8; ++j) f[j] = T[q * 4160 + n * 65 + kc + j];
            const int drow = perm ? dest_of_orig(nb * 64 + n) : nb * 64 + n;
            *(u32x4*)(dst + (size_t)drow * K + kb * 64 + kc) = pack8(f);
        }
        __syncthreads();
    }
}

__device__ __forceinline__ void norm_phase(const Params& P, int l) {
    int tid_l = threadIdx.x; asm volatile("" : "+v"(tid_l));
    const int tid = tid_l, lane = tid & 63, wv = tid >> 6;
    bf16_t* XN = (bf16_t*)(P.ws + WS_XN); float* HMETA = (float*)(P.ws + WS_HMETA);
    for (int row = blockIdx.x * 8 + wv; row < NROW; row += gridDim.x * 8) {
        int b, p; row_bp(row, b, p);
        bf16_t* xr = XN + (size_t)row * 1024;
        if (l == DEPTH && p < 64) continue;
        if (p < NPAD) {
            if (l < DEPTH) {
#pragma unroll
                for (int k = 0; k < 4; ++k) *(u32x2*)(xr + 256 * k + 4 * lane) = (u32x2){0u, 0u};
            }
            continue;
        }
        float* hp = p >= 64 ? P.out + (size_t)(b * SEQ + p - 64) * 1024 : HMETA + (size_t)(b * 16 + p - NPAD) * 1024;
        f32x4 v[4];
        if (l == 0) {
            const float* src = p >= 64 ? P.x + (size_t)(b * SEQ + p - 64) * 1024 : P.meta + (size_t)(p - NPAD) * 1024;
#pragma unroll
            for (int k = 0; k < 4; ++k) v[k] = __builtin_nontemporal_load((const f32x4*)(src + 256 * k + 4 * lane));
        } else {
            f32x4 o[4], hv[4]; float ss = 0.f;
            const float* hsrc = (l == 1 && p >= 64) ? P.x + (size_t)(b * SEQ + p - 64) * 1024 : hp;
#pragma unroll
            for (int k = 0; k < 4; ++k) hv[k] = __builtin_nontemporal_load((const f32x4*)(hsrc + 256 * k + 4 * lane));
#pragma unroll
            for (int k = 0; k < 4; ++k) { const u32x2 raw = __builtin_nontemporal_load((const u32x2*)(xr + 256 * k + 4 * lane)); o[k] = (f32x4){bflo(raw.x), bfhi(raw.x), bflo(raw.y), bfhi(raw.y)};
                ss += o[k][0] * o[k][0] + o[k][1] * o[k][1] + o[k][2] * o[k][2] + o[k][3] * o[k][3]; }
            ss = wave_sum(ss); const float rs = rsqrtf(ss * (1.0f / 1024.0f) + 1e-6f);
#pragma unroll
            for (int k = 0; k < 4; ++k) { const f32x4 g = *(const f32x4*)(P.post_g + (size_t)(l - 1) * 1024 + 256 * k + 4 * lane);
                v[k] = hv[k] + o[k] * rs * g; }
        }
        if (l != 0 || p < 64) {
#pragma unroll
            for (int k = 0; k < 4; ++k) __builtin_nontemporal_store(v[k], (f32x4*)(hp + 256 * k + 4 * lane));
        }
        if (l == DEPTH) continue;
        float s2 = 0.f;
#pragma unroll
        for (int k = 0; k < 4; ++k) s2 += v[k][0] * v[k][0] + v[k][1] * v[k][1] + v[k][2] * v[k][2] + v[k][3] * v[k][3];
        s2 = wave_sum(s2); const float r2 = rsqrtf(s2 * (1.0f / 1024.0f) + 1e-6f);
#pragma unroll
        for (int k = 0; k < 4; ++k) { const f32x4 g = *(const f32x4*)(P.pre_g + (size_t)l * 1024 + 256 * k + 4 * lane); const f32x4 y = v[k] * r2 * g;
            *(u32x2*)(xr + 256 * k + 4 * lane) = (u32x2){pk(y[0], y[1]), pk(y[2], y[3])}; }
    }
}

__device__ __forceinline__ bf16x8 tr2(LAS unsigned char* a0, LAS unsigned char* a1) {
    const s16x4 t0 = __builtin_amdgcn_ds_read_tr16_b64_v4i16((LAS s16x4*)a0), t1 = __builtin_amdgcn_ds_read_tr16_b64_v4i16((LAS s16x4*)a1);
    return __builtin_shufflevector(t0, t1, 0, 1, 2, 3, 4, 5, 6, 7);
}
__device__ __forceinline__ void scan_phase(LAS unsigned char* lds, const Params& P) {
    constexpr int QP = 528, VP = 144, OFF_Q = 0, OFF_K = 64 * QP, OFF_SB = 2 * 64 * QP, OFF_V = 3 * 64 * QP, OFF_P = OFF_V + 64 * VP, OFF_O = OFF_P + 64 * VP;
    static_assert(OFF_O + 64 * VP <= 131072, "scan LDS");
    int tid_l = threadIdx.x; asm volatile("" : "+v"(tid_l));
    const int tid = tid_l, lane = tid & 63, w = __builtin_amdgcn_readfirstlane(tid >> 6);
    const bf16_t* Q = (const bf16_t*)(P.ws + WS_Q); const bf16_t* K = (const bf16_t*)(P.ws + WS_K); bf16_t* VH = (bf16_t*)(P.ws + WS_VH);
    float2* STAT = (float2*)(P.ws + WS_STAT);
    const int mb = w >> 1, nb0 = 2 * (w & 1), rb = w >> 1, cb0 = 2 * (w & 1);
    for (int cidx = blockIdx.x; cidx < 256; cidx += gridDim.x) {
        const int chain = (cidx & 7) * 32 + (cidx >> 3);
        const int b = chain >> 5, hd = (chain >> 3) & 3, sl = chain & 7; const float lg = lg_gamma(hd);
        f32x16 S[2];
#pragma unroll
        for (int i = 0; i < 16; ++i) { S[0][i] = 0.f; S[1][i] = 0.f; }
        for (int i = tid; i < 64 * QP / 16; i += 512) *(LAS u32x4*)(lds + OFF_SB + 16 * i) = (u32x4){0u, 0u, 0u, 0u};
        u32x4 qr[4], kr[4], vr;
#define SCAN_LOADQ(ci_) do { const bf16_t* qb_ = Q + (size_t)((b * 4 + hd) * LP + 64 * (ci_)) * 256; _Pragma("unroll") for (int i = 0; i < 4; ++i) qr[i] = *(const u32x4*)(qb_ + (tid + 512 * i) * 8); } while (0)
#define SCAN_LOADK(ci_) do { const bf16_t* kb_ = K + (size_t)((b * 4 + hd) * LP + 64 * (ci_)) * 256; _Pragma("unroll") for (int i = 0; i < 4; ++i) kr[i] = *(const u32x4*)(kb_ + (tid + 512 * i) * 8); } while (0)
#define SCAN_VPTR(ci_) (VH + (size_t)(((b * 4 + hd) * 8 + sl) * LP + 64 * (ci_)) * 64 + tid * 8)
#define SCAN_LOADV(ci_) do { vr = __builtin_nontemporal_load((const u32x4*)SCAN_VPTR(ci_)); } while (0)
#define SCAN_LOAD(ci_) do { SCAN_LOADQ(ci_); SCAN_LOADK(ci_); SCAN_LOADV(ci_); } while (0)
#define SCAN_STORE() do { _Pragma("unroll") for (int i = 0; i < 4; ++i) { const int id = tid + 512 * i, row = id >> 5, ch = id & 31; \
            *(LAS u32x4*)(lds + OFF_Q + row * QP + ch * 16) = qr[i]; *(LAS u32x4*)(lds + OFF_K + row * QP + ch * 16) = kr[i]; } \
            *(LAS u32x4*)(lds + OFF_V + (tid >> 3) * VP + (tid & 7) * 16) = vr; } while (0)
        SCAN_LOAD(0); SCAN_STORE(); LBAR();
        for (int ci = 0; ci < NCH; ++ci) {
            int lane_v = lane; asm volatile("" : "+v"(lane_v));
            const int lr = lane_v & 15, g = lane_v >> 4, l31 = lane_v & 31, hh = lane_v >> 5, blk = (lane_v >> 4) & 1, q4 = (lane_v & 15) >> 2, p4 = lane_v & 3;
            if (ci > 0) __builtin_nontemporal_store(*(const LAS u32x4*)(lds + OFF_O + (tid >> 3) * VP + (tid & 7) * 16), (u32x4*)SCAN_VPTR(ci - 1));
            if (ci + 1 < NCH) SCAN_LOADQ(ci + 1);
            float ov[4][2];
            bf16x8 qf[8];
            {
                f32x4 accP[2] = {(f32x4){0.f, 0.f, 0.f, 0.f}, (f32x4){0.f, 0.f, 0.f, 0.f}};
#pragma unroll
                for (int hb = 0; hb < 2; ++hb) {
                    bf16x8 kf[2][4];
#pragma unroll
                    for (int k4 = 0; k4 < 4; ++k4) { const int ks = 4 * hb + k4;
                        qf[ks] = *(const LAS bf16x8*)(lds + OFF_Q + (16 * rb + lr) * QP + (32 * ks + 8 * g) * 2);
#pragma unroll
                        for (int t = 0; t < 2; ++t) kf[t][k4] = *(const LAS bf16x8*)(lds + OFF_K + (16 * (cb0 + t) + lr) * QP + (32 * ks + 8 * g) * 2); }
                    __builtin_amdgcn_sched_barrier(0);
#pragma unroll
                    for (int k4 = 0; k4 < 4; ++k4)
#pragma unroll
                        for (int t = 0; t < 2; ++t) accP[t] = __builtin_amdgcn_mfma_f32_16x16x32_bf16(kf[t][k4], qf[4 * hb + k4], accP[t], 0, 0, 0);
                    __builtin_amdgcn_sched_barrier(0);
                }
                const int n = 16 * rb + lr;
#pragma unroll
                for (int t = 0; t < 2; ++t) { float pv[4];
#pragma unroll
                    for (int rg = 0; rg < 4; ++rg) { const int m = 16 * (cb0 + t) + 4 * g + rg, d = m - n; pv[rg] = accP[t][rg] * ex2(lg * (float)(-64 + (d > 0 ? 2 * d : 0))); }
                    *(LAS u32x2*)(lds + OFF_P + n * VP + (16 * (cb0 + t) + 4 * g) * 2) = (u32x2){pk(pv[0], pv[1]), pk(pv[2], pv[3])}; }
            }
            LBAR();
            if (ci + 1 < NCH) SCAN_LOADK(ci + 1);
            {
                f32x4 accO[2] = {(f32x4){0.f, 0.f, 0.f, 0.f}, (f32x4){0.f, 0.f, 0.f, 0.f}};
                bf16x8 pf[2], vf[2][2];
#pragma unroll
                for (int hb = 0; hb < 2; ++hb) {
                    bf16x8 sf[2][4];
#pragma unroll
                    for (int k4 = 0; k4 < 4; ++k4)
#pragma unroll
                        for (int t = 0; t < 2; ++t) sf[t][k4] = *(const LAS bf16x8*)(lds + OFF_SB + (16 * (cb0 + t) + lr) * QP + (32 * (4 * hb + k4) + 8 * g) * 2);
                    if (hb == 1) {
#pragma unroll
                        for (int ks = 0; ks < 2; ++ks) {
                            pf[ks] = *(const LAS bf16x8*)(lds + OFF_P + (16 * rb + lr) * VP + (32 * ks + 8 * g) * 2);
#pragma unroll
                            for (int t = 0; t < 2; ++t) { LAS unsigned char* base = lds + OFF_V + (32 * ks + 8 * g + q4) * VP + (16 * (cb0 + t) + 4 * p4) * 2; vf[t][ks] = tr2(base, base + 4 * VP); }
                        }
                    }
                    __builtin_amdgcn_sched_barrier(0);
#pragma unroll
                    for (int k4 = 0; k4 < 4; ++k4)
#pragma unroll
                        for (int t = 0; t < 2; ++t) accO[t] = __builtin_amdgcn_mfma_f32_16x16x32_bf16(qf[4 * hb + k4], sf[t][k4], accO[t], 0, 0, 0);
                    __builtin_amdgcn_sched_barrier(0);
                }
#pragma unroll
                for (int ks = 0; ks < 2; ++ks)
#pragma unroll
                    for (int t = 0; t < 2; ++t) accO[t] = __builtin_amdgcn_mfma_f32_16x16x32_bf16(pf[ks], vf[t][ks], accO[t], 0, 0, 0);
#pragma unroll
                for (int rg = 0; rg < 4; ++rg) { const float sc = ex2(lg * (float)(16 * rb + 4 * g + rg + 1)); ov[rg][0] = accO[0][rg] * sc; ov[rg][1] = accO[1][rg] * sc; }
            }
            if (ci + 1 < NCH) SCAN_LOADV(ci + 1);
            {
                bf16x8 af[4], bf[2][4];
#pragma unroll
                for (int ks = 0; ks < 4; ++ks) {
                    LAS unsigned char* ab = lds + OFF_K + (16 * ks + 8 * hh + q4) * QP + (32 * w + 16 * blk + 4 * p4) * 2;
                    af[ks] = tr2(ab, ab + 4 * QP);
#pragma unroll
                    for (int tv = 0; tv < 2; ++tv) { LAS unsigned char* bb = lds + OFF_V + (16 * ks + 8 * hh + q4) * VP + (32 * tv + 16 * blk + 4 * p4) * 2; bf[tv][ks] = tr2(bb, bb + 4 * VP); }
                }
                const float cd = ex2(lg * 64.0f);
                S[0] *= cd; S[1] *= cd;
                __builtin_amdgcn_sched_barrier(0);
#pragma unroll
                for (int ks = 0; ks < 4; ++ks)
#pragma unroll
                    for (int tv = 0; tv < 2; ++tv) S[tv] = __builtin_amdgcn_mfma_f32_32x32x16_bf16(af[ks], bf[tv][ks], S[tv], 0, 0, 0);
            }
            LBAR();
#pragma unroll
            for (int tv = 0; tv < 2; ++tv)
#pragma unroll
                for (int rg = 0; rg < 4; ++rg)
                    *(LAS u32x2*)(lds + OFF_SB + (32 * tv + l31) * QP + (32 * w + 8 * rg + 4 * hh) * 2) = (u32x2){pk(S[tv][4 * rg], S[tv][4 * rg + 1]), pk(S[tv][4 * rg + 2], S[tv][4 * rg + 3])};
#pragma unroll
            for (int rg = 0; rg < 4; ++rg)
#pragma unroll
                for (int t = 0; t < 2; ++t) *(LAS bf16_t*)(lds + OFF_O + (16 * rb + 4 * g + rg) * VP + (16 * (cb0 + t) + lr) * 2) = (bf16_t)(pk(ov[rg][t], 0.f) & 0xffffu);
            if (ci + 1 < NCH) SCAN_STORE();
            LBAR();
        }
        __builtin_nontemporal_store(*(const LAS u32x4*)(lds + OFF_O + (tid >> 3) * VP + (tid & 7) * 16), (u32x4*)SCAN_VPTR(NCH - 1));
        LBAR();
#undef SCAN_LOAD
#undef SCAN_STORE
    }
}

__device__ __forceinline__ void elem_phase(LAS unsigned char* lds, const Params& P, int l) {
    int tid_l = threadIdx.x; asm volatile("" : "+v"(tid_l));
    const int tid = tid_l, lane = tid & 63, wv = tid >> 6;
    const bf16_t* U = (const bf16_t*)(P.ws + WS_U); bf16_t* MG = (bf16_t*)(P.ws + WS_MG); const bf16_t* RET = (const bf16_t*)(P.ws + WS_VH); bf16_t* A2 = (bf16_t*)(P.ws + WS_Q); const bf16_t* SZ = (const bf16_t*)(P.ws + WS_SZ);
    const f32x2* STAT = (const f32x2*)(P.ws + WS_STAT);
    f32x4 cw[2][4][2], gg[4][2];
#pragma unroll
    for (int k = 0; k < 2; ++k) { const int c8 = (lane + 64 * k) * 8;
#pragma unroll
        for (int j = 0; j < 3; ++j) { cw[k][j][0] = *(const f32x4*)(P.conv_w + (size_t)l * 3072 + j * 1024 + c8); cw[k][j][1] = *(const f32x4*)(P.conv_w + (size_t)l * 3072 + j * 1024 + c8 + 4); }
        cw[k][3][0] = *(const f32x4*)(P.conv_b + (size_t)l * 1024 + c8); cw[k][3][1] = *(const f32x4*)(P.conv_b + (size_t)l * 1024 + c8 + 4); }
#pragma unroll
    for (int k = 0; k < 4; ++k) { const int c = (lane + 64 * k) * 8; gg[k][0] = *(const f32x4*)(P.gn_g + (size_t)l * 2048 + c); gg[k][1] = *(const f32x4*)(P.gn_g + (size_t)l * 2048 + c + 4); }
    const int vblk = (gridDim.x == 256) ? (int)((blockIdx.x & 7) * 32 + (blockIdx.x >> 3)) : (int)blockIdx.x;
    for (int row = vblk * 8 + wv; row < NROW; row += gridDim.x * 8) {
        int b, p; row_bp(row, b, p);
        if (p < NPAD || (l == DEPTH - 1 && p < 64)) continue;
        const int rm1 = bp_row(b, p - 1 >= NPAD ? p - 1 : NPAD), rm2 = bp_row(b, p - 2 >= NPAD ? p - 2 : NPAD);
        u32x4 ur[2][3], mr[2], rr[4], zr[4];
#pragma unroll
        for (int k = 0; k < 2; ++k) { const int c8 = (lane + 64 * k) * 8;
            ur[k][2] = *(const u32x4*)(U + (size_t)row * 1024 + c8); mr[k] = __builtin_nontemporal_load((const u32x4*)(MG + (size_t)row * 1024 + c8));
            ur[k][1] = (p - 1 >= NPAD) ? *(const u32x4*)(U + (size_t)rm1 * 1024 + c8) : (u32x4){0u, 0u, 0u, 0u};
            ur[k][0] = (p - 2 >= NPAD) ? *(const u32x4*)(U + (size_t)rm2 * 1024 + c8) : (u32x4){0u, 0u, 0u, 0u}; }
#pragma unroll
        for (int k = 0; k < 4; ++k) { const int c = (lane + 64 * k) * 8; rr[k] = __builtin_nontemporal_load((const u32x4*)(RET + (size_t)(((b * 4 + k) * 8 + (lane >> 3)) * LP + p) * 64 + (lane & 7) * 8)); zr[k] = __builtin_nontemporal_load((const u32x4*)(SZ + (size_t)row * 2048 + c)); }
#pragma unroll
        for (int k = 0; k < 2; ++k) { const int c8 = (lane + 64 * k) * 8; float u0[8], u1[8], u2[8], mg[8], o[8];
            unpack8(ur[k][0], u0); unpack8(ur[k][1], u1); unpack8(ur[k][2], u2); unpack8(mr[k], mg);
#pragma unroll
            for (int e = 0; e < 8; ++e) o[e] = mg[e] * (cw[k][3][e >> 2][e & 3] + cw[k][0][e >> 2][e & 3] * u0[e] + cw[k][1][e >> 2][e & 3] * u1[e] + cw[k][2][e >> 2][e & 3] * u2[e]);
            *(u32x4*)(MG + (size_t)row * 1024 + c8) = pack8(o); }
#pragma unroll
        for (int k = 0; k < 4; ++k) { const int c = (lane + 64 * k) * 8;
            float rv[8], sz[8], o[8]; unpack8(rr[k], rv); unpack8(zr[k], sz);
            float s1 = 0.f, s2 = 0.f;
#pragma unroll
            for (int e = 0; e < 8; ++e) { s1 += rv[e]; s2 += rv[e] * rv[e]; }
            s1 = wave_sum(s1); s2 = wave_sum(s2);
            const float mk = s1 * (1.0f / 512.0f); float var = s2 * (1.0f / 512.0f) - mk * mk; var = var > 0.f ? var : 0.f; const float rk = rsqrtf(var + 1e-5f);
#pragma unroll
            for (int e = 0; e < 8; ++e) o[e] = (rv[e] - mk) * rk * gg[k][e >> 2][e & 3] * silu_f(sz[e]);
            *(u32x4*)(A2 + (size_t)row * 2048 + c) = pack8(o); }
    }
    __syncthreads();
}


#define XB_TMO      128
#define XB_XCNT(j)  (256  + 64 * (j))
#define XB_XSUB(j)  (1280 + 64 * (j))
#define XB_XGEN(j)  (2304 + 64 * (j))
#define XB_TOP      3328
#define XB_TOPGEN   3392
#define XCD_BAR_WORDS 3456
#define XB_SPIN_CAP (1u << 18)

__device__ __forceinline__ unsigned xb_ld(unsigned* p)              { return __hip_atomic_load(p, __ATOMIC_RELAXED, __HIP_MEMORY_SCOPE_AGENT); }
__device__ __forceinline__ unsigned xb_add(unsigned* p, unsigned v) { return __hip_atomic_fetch_add(p, v, __ATOMIC_RELAXED, __HIP_MEMORY_SCOPE_AGENT); }
__device__ __forceinline__ unsigned xb_xcc_id() { return (unsigned)__builtin_amdgcn_s_getreg((3 << 11) | 20) & 0xFu; }
#define XB_SPIN(cond, bar) do { unsigned _sp = 0; while (cond) { __builtin_amdgcn_s_sleep(1); \
    if ((++_sp & 255u) == 0u) { if (xb_ld(&(bar)[XB_TMO])) break; if (_sp > XB_SPIN_CAP) { atomicAdd(&(bar)[XB_TMO], 1u); break; } } } } while (0)

struct XcdBarrier {
    unsigned* bar; unsigned x;
    volatile LAS unsigned* st;
};

__device__ __forceinline__ XcdBarrier xcd_barrier_post(unsigned* bar, volatile LAS unsigned* st) {
    XcdBarrier b; b.bar = bar; b.x = xb_xcc_id(); b.st = st;
    if (threadIdx.x == 0) (void)xb_add(&bar[XB_XCNT(b.x)], 1u);
    return b;
}
__device__ __forceinline__ void xcd_barrier_complete(unsigned* bar, unsigned x, unsigned& nloc, unsigned& nx) {
    const unsigned G = gridDim.x * gridDim.y * gridDim.z;
    unsigned sum, cnt, mine, sp = 0u;
    for (;;) {
        sum = 0u; cnt = 0u; mine = 0u;
#pragma unroll
        for (unsigned j = 0; j < 16; ++j) { const unsigned c = xb_ld(&bar[XB_XCNT(j)]); sum += c; cnt += (c > 0u) ? 1u : 0u; mine = (j == x) ? c : mine; }
        if (sum == G) break;
        __builtin_amdgcn_s_sleep(1);
        if ((++sp & 255u) == 0u) { if (xb_ld(&bar[XB_TMO])) break; if (sp > XB_SPIN_CAP) { atomicAdd(&bar[XB_TMO], 1u); break; } }
    }
    nloc = mine > 0u ? mine : 1u; nx = cnt > 0u ? cnt : 1u;
}

__device__ __forceinline__ void xcd_barrier(const XcdBarrier& b) {
    asm volatile("s_waitcnt vmcnt(0)" ::: "memory");
    __syncthreads();
    if (threadIdx.x == 0) {
        unsigned* bar = b.bar;
        __builtin_amdgcn_s_waitcnt(0);
        unsigned nloc = b.st[0], nx = b.st[1];
        if (nloc == 0u) { xcd_barrier_complete(bar, b.x, nloc, nx); b.st[0] = nloc; b.st[1] = nx; }
        const unsigned old = xb_add(&bar[XB_XSUB(b.x)], 1u);
        const unsigned gen = old / nloc;
        if (old + 1u == (gen + 1u) * nloc) {
            __builtin_amdgcn_fence(__ATOMIC_RELEASE, "agent");
            asm volatile("s_waitcnt vmcnt(0)" ::: "memory");
            const unsigned og = xb_add(&bar[XB_TOP], 1u);
            const unsigned tg = og / nx;
            if (og + 1u == (tg + 1u) * nx) xb_add(&bar[XB_TOPGEN], 1u);
            else XB_SPIN(xb_ld(&bar[XB_TOPGEN]) == tg, bar);
            __builtin_amdgcn_fence(__ATOMIC_ACQUIRE, "agent");
            xb_add(&bar[XB_XGEN(b.x)], 1u);
            asm volatile("s_waitcnt vmcnt(0)" ::: "memory");
        } else {
            XB_SPIN(xb_ld(&bar[XB_XGEN(b.x)]) == gen, bar);
            __builtin_amdgcn_fence(__ATOMIC_ACQUIRE, "agent");
            asm volatile("s_waitcnt vmcnt(0)" ::: "memory");
        }
    }
    __syncthreads();
}


__global__ void __launch_bounds__(512) hybrid_trunk_fwd(Params P) {
    extern __shared__ __attribute__((aligned(16))) unsigned char lds_raw[];
    LAS unsigned char* lds = (LAS unsigned char*)lds_raw;
    cg::grid_group grid = cg::this_grid();
    unsigned char* ws = P.ws;
    bf16_t* XN = (bf16_t*)(ws + WS_XN); bf16_t* U = (bf16_t*)(ws + WS_U); bf16_t* MG = (bf16_t*)(ws + WS_MG); bf16_t* Q = (bf16_t*)(ws + WS_Q); bf16_t* K = (bf16_t*)(ws + WS_K);
    bf16_t* VH = (bf16_t*)(ws + WS_VH); bf16_t* SZ = (bf16_t*)(ws + WS_SZ); bf16_t* GA = (bf16_t*)(ws + WS_GA); bf16_t* GB = (bf16_t*)(ws + WS_GB);
    const bf16_t* WIN = (const bf16_t*)(ws + WS_WIN); const bf16_t* WCO = (const bf16_t*)(ws + WS_WCO); const bf16_t* WRO = (const bf16_t*)(ws + WS_WRO); const bf16_t* WO = (const bf16_t*)(ws + WS_WO);
    const float* BP = (const float*)(ws + WS_BP); const float* CT = (const float*)(ws + WS_ROPE); const float* ST = CT + 4112 * 128;
    const int G = gridDim.x, c = blockIdx.x;
    unsigned* barw = (unsigned*)(ws + WS_BAR);
    volatile LAS unsigned* bst = (volatile LAS unsigned*)(lds + 131072);
    if (threadIdx.x < 4) bst[threadIdx.x] = 0u;
    __syncthreads();
    if (P.ws == nullptr) grid.sync();
    XcdBarrier xbar = xcd_barrier_post(barw, bst);
#define GSYNC() xcd_barrier(xbar)
#if defined(PROBE_DUR)
    unsigned long long tph[6] = {0ull, 0ull, 0ull, 0ull, 0ull, 0ull}; const unsigned long long tstart = __builtin_amdgcn_s_memrealtime(); unsigned long long tlast = tstart;
#define PSTAMP(k) do { const unsigned long long tn_ = __builtin_amdgcn_s_memrealtime(); tph[k] += tn_ - tlast; tlast = tn_; } while (0)
#else
#define PSTAMP(k) do { } while (0)
#endif
    for (int l = 0; l < DEPTH; ++l) {
        convert_phase(lds, P, l);
        norm_phase(P, l);
        GSYNC(); PSTAMP(0);
        { int ti_b = threadIdx.x; asm volatile("" : "+v"(ti_b));
          for (int i = ti_b; i < DIN / 4; i += 512) { const f32x4 bq = *(const f32x4*)(BP + 4 * i); *(LAS u32x2*)(lds + LDS_BIAS + 8 * i) = (u32x2){pk(bq[0], bq[1]), pk(bq[2], bq[3])}; }
          __syncthreads(); }
        { pg8::Gemm g{XN, WIN, NROW, DIN, 1024}; pg8::StaticOrder S; S.init(NROW, DIN, G, c); EpiIn E{U, MG, Q, K, VH, SZ, GA, GB, (const LAS bf16_t*)(lds + LDS_BIAS), CT, ST};
          pg8::gemm_phase<EpiIn, pg8::StaticOrder>(lds, g, S, E, nullptr); }
        GSYNC(); PSTAMP(1);
        scan_phase(lds, P);
        GSYNC(); PSTAMP(2);
        elem_phase(lds, P, l);
        GSYNC(); PSTAMP(3);
        if (l + 1 < DEPTH) { meta_gemm<1>(MG, WCO, 1024, 1024, GA, U, nullptr, nullptr); meta_gemm<2>(Q, WRO, 2048, 1024, GB, U, nullptr, nullptr); }
        { pg8::Gemm g{MG, WCO, NREAL, 1024, 1024}; pg8::StaticOrder S; S.init(NREAL, 1024, G, c); EpiOut<1> E{GA, U, nullptr, nullptr};
          pg8::gemm_phase<EpiOut<1>, pg8::StaticOrder>(lds, g, S, E, nullptr); }
        { pg8::Gemm g{Q, WRO, NREAL, 1024, 2048}; pg8::StaticOrder S; S.init(NREAL, 1024, G, c); EpiOut<2> E{GB, U, nullptr, nullptr};
          pg8::gemm_phase<EpiOut<2>, pg8::StaticOrder>(lds, g, S, E, nullptr); }
        GSYNC(); PSTAMP(4);
        if (l + 1 < DEPTH) meta_gemm<3>(U, WO, 1024, 1024, nullptr, XN, nullptr, nullptr);
        { pg8::Gemm g{U, WO, NREAL, 1024, 1024}; pg8::StaticOrder S; S.init(NREAL, 1024, G, c); EpiOut<3> E{nullptr, XN, nullptr, nullptr};
          pg8::gemm_phase<EpiOut<3>, pg8::StaticOrder>(lds, g, S, E, nullptr); }
        GSYNC(); PSTAMP(5);
    }
    norm_phase(P, DEPTH);
#if defined(PROBE_DUR)
    GSYNC(); PSTAMP(0);
    {
        const unsigned long long ttot = tlast - tstart;
        const int M = (int)((double)tph[PROBE_RVR] * 1.0e6 / (double)ttot);
        for (int idx = blockIdx.x * 512 + threadIdx.x; idx < M; idx += gridDim.x * 512) P.out[idx] += 0.4f;
        const unsigned long long tend = __builtin_amdgcn_s_memrealtime() + tph[PROBE_DUR];
        while (__builtin_amdgcn_s_memrealtime() < tend) __builtin_amdgcn_s_sleep(8);
    }
#endif
}

extern "C" void kernel_launch(void* const* d_in, const int* in_sizes, int n_in, void* d_out, int out_size, void* d_ws, size_t ws_size, hipStream_t stream) {
    static int grid = 0;
    if (grid == 0) {
        int dev = 0, cus = 0, per_cu = 0;
        hipGetDevice(&dev); hipDeviceGetAttribute(&cus, hipDeviceAttributeMultiprocessorCount, dev);
        hipFuncSetAttribute((const void*)hybrid_trunk_fwd, hipFuncAttributeMaxDynamicSharedMemorySize, LDS_BYTES);
        hipOccupancyMaxActiveBlocksPerMultiprocessor(&per_cu, (const void*)hybrid_trunk_fwd, 512, LDS_BYTES);
        (void)hipGetLastError();
        if (per_cu < 1) per_cu = 1;
        grid = cus * per_cu;
        if (n_in != 12 || ws_size < WS_END) { fprintf(stderr, "kernel_launch: n_in %d ws %zu need %zu\n", n_in, ws_size, (size_t)WS_END); grid = -1; }
    }
    if (grid < 0) return;
    Params p{};
    p.x = (const float*)d_in[0]; p.meta = (const float*)d_in[1]; p.pre_g = (const float*)d_in[2]; p.w_in = (const float*)d_in[3]; p.b_in = (const float*)d_in[4];
    p.conv_w = (const float*)d_in[5]; p.conv_b = (const float*)d_in[6]; p.w_co = (const float*)d_in[7]; p.gn_g = (const float*)d_in[8]; p.w_ro = (const float*)d_in[9];
    p.w_o = (const float*)d_in[10]; p.post_g = (const float*)d_in[11]; p.out = (float*)d_out; p.ws = (unsigned char*)d_ws;
    hipMemsetAsync((char*)d_ws + WS_BAR, 0, 16384, stream);
    void* args[] = {&p};
    hipError_t e = hipLaunchCooperativeKernel((const void*)hybrid_trunk_fwd, dim3(grid), dim3(512), args, LDS_BYTES, stream);
    if (e != hipSuccess) fprintf(stderr, "cooperative launch failed: %s (grid %d)\n", hipGetErrorString(e), grid);
}
```

```cpp
#include <hip/hip_runtime.h>
#include <hip/hip_cooperative_groups.h>
#include <cstdio>
namespace cg = cooperative_groups;
namespace pg8 {
#define PG8_LAS __attribute__((address_space(3)))
typedef unsigned short bf16_t;
typedef short bf16x8 __attribute__((ext_vector_type(8)));
typedef float f32x4 __attribute__((ext_vector_type(4)));
typedef unsigned u32x4 __attribute__((ext_vector_type(4)));
constexpr int BM = 256, BK = 64, HALF = 128, HTB = HALF * BK * 2  , STAGE_BYTES = 8 * HTB, NXCD = 8, WGM = 8;

__host__ __device__ __forceinline__ int lds_byte(int r, int c) { const int st = (r >> 4) * 2 + (c >> 5), rr = r & 15, cc = c & 31, ob = rr * 64 + cc * 2; return st * 1024 + (ob ^ (((ob >> 9) & 1) << 5)); }
__host__ __device__ __forceinline__ void stage_rc(int b, int& R, int& C) { const int st = b / 1024, sb = b % 1024, swz = sb ^ (((sb >> 9) & 1) << 5); R = (st >> 1) * 16 + swz / 64; C = (st & 1) * 32 + (swz % 64) / 2; }
__host__ __device__ __forceinline__ int perm32(int rho) { const int n = rho >> 4, i = rho & 15; return 8 * (i >> 2) + 4 * n + (i & 3); }

struct Unit { int pm, pn; };
struct Gemm { const bf16_t* A; const bf16_t* Bt; int M, N, K; };

struct StaticOrder {
    int nM, nN, nwg, G, c;
    __host__ __device__ void init(int M, int N, int G_, int c_) { nM = M / BM; nN = N / BM; nwg = nM * nN; G = G_; c = c_; }
    __host__ __device__ bool next(int i, Unit& u) const {
        const long L = (long)i * G + c; if (L >= nwg) return false;
        int wgid = (int)L; { const int q = nwg / NXCD, r = nwg % NXCD, xcd = wgid % NXCD, off = wgid / NXCD; wgid = (xcd < r ? xcd * (q + 1) : r * (q + 1) + (xcd - r) * q) + off; }
        const int nig = WGM * nN, gid = wgid / nig, fm = gid * WGM, gsz = (nM - fm) < WGM ? (nM - fm) : WGM;
        u.pm = fm + ((wgid % nig) % gsz); u.pn = (wgid % nig) / gsz; return true;
    }
    __device__ __forceinline__ void a_ready(const Unit&) const {}
    __device__ __forceinline__ void done(const Unit&) const {}
};
struct CountedOrder : StaticOrder {
    const unsigned* ready; unsigned need; unsigned* tmo;
    __device__ __forceinline__ void a_ready(const Unit& u) const {
        if (threadIdx.x < 64) {
            const unsigned long long t0 = __builtin_amdgcn_s_memrealtime(); unsigned polls = 0;
            while ((unsigned)__builtin_amdgcn_readfirstlane(__hip_atomic_load(ready + 64 * u.pm, __ATOMIC_RELAXED, __HIP_MEMORY_SCOPE_AGENT)) < need) {
                if ((++polls & 255u) == 0u && __builtin_amdgcn_readfirstlane(__hip_atomic_load(tmo, __ATOMIC_RELAXED, __HIP_MEMORY_SCOPE_AGENT)) != 0u) break;
                if (__builtin_amdgcn_s_memrealtime() - t0 > 2000000ull) {
                    if (threadIdx.x == 0) { unsigned expect = 0u; __hip_atomic_compare_exchange_strong(tmo + 1, &expect, 0x600u | (unsigned)(u.pm & 0xff), __ATOMIC_RELAXED, __ATOMIC_RELAXED, __HIP_MEMORY_SCOPE_AGENT); __hip_atomic_store(tmo, 1u, __ATOMIC_RELAXED, __HIP_MEMORY_SCOPE_AGENT); }
                    break; }
                __builtin_amdgcn_s_sleep(2); }
            __builtin_amdgcn_fence(__ATOMIC_ACQUIRE, "agent");
            asm volatile("s_waitcnt vmcnt(0)" ::: "memory");
        }
#if !defined(BROKEN_HOOK_NO_BARRIER)
        asm volatile("" ::: "memory"); __builtin_amdgcn_s_barrier(); asm volatile("" ::: "memory");
#endif
    }
};

__device__ __forceinline__ unsigned cvt_pk_bf16(float lo, float hi) { unsigned r; asm volatile("v_cvt_pk_bf16_f32 %0, %1, %2" : "=v"(r) : "v"(lo), "v"(hi)); return r; }
typedef float f32x2 __attribute__((ext_vector_type(2)));
__device__ __forceinline__ f32x2 gelu_pk(f32x2 v) {
    const f32x2 av = __builtin_elementwise_abs(v), d = av * 0.2316418882f + 1.0f;
    f32x2 t; t.x = __builtin_amdgcn_rcpf(d.x); t.y = __builtin_amdgcn_rcpf(d.y);
    f32x2 q = t * 0.5307027145f + (-0.7265760135f); q = q * t + 0.7107068705f; q = q * t + (-0.142248368f); q = q * t + 0.127414796f; q = q * t;
    const f32x2 s = (v * v) * (-0.72134752044f);
    f32x2 e; e.x = __builtin_amdgcn_exp2f(s.x); e.y = __builtin_amdgcn_exp2f(s.y);
    const f32x2 m = v * (q * e), r = v - m;
    f32x2 o; o.x = v.x < 0.f ? m.x : r.x; o.y = v.y < 0.f ? m.y : r.y; return o;
}

template <class Epi, class Sched, bool STAMP = false>
__device__ __forceinline__ void gemm_phase(PG8_LAS unsigned char* lds, const Gemm g, const Sched& S, const Epi& E, unsigned long long* stamps) {
    int tid_l = threadIdx.x; asm volatile("" : "+v"(tid_l));
    const int tid = tid_l, wid = __builtin_amdgcn_readfirstlane(tid >> 6), lane = tid & 63, wr = wid >> 2, wc = wid & 3, fr = lane & 15, fq = lane >> 4;
    const int K = g.K, nt = K / BK;
    int ts_lo = 0, ts_hi = 0, nts = 0; const unsigned long long rt_entry = STAMP ? (unsigned long long)wall_clock64() : 0ull;
#define PG8_STAMP() do { if (STAMP && wid == 0 && nts < 64) { const unsigned long long _c = (unsigned long long)clock64(); \
        ts_lo = (lane == nts) ? (int)(unsigned)_c : ts_lo; ts_hi = (lane == nts) ? (int)(unsigned)(_c >> 32) : ts_hi; ++nts; } } while (0)
    PG8_STAMP();
    unsigned voffA[2], voffB[2];
#pragma unroll
    for (int i = 0; i < 2; ++i) { int R, C; stage_rc(tid * 16 + i * 8192, R, C); const int Rb = Epi::PERM ? ((R & ~31) + perm32(R & 31)) : R;
        voffA[i] = (unsigned)(R * K + C) * 2u; voffB[i] = (unsigned)(Rb * K + C) * 2u; }
    const size_t kstep = (size_t)(BK * 2);
    const size_t hstep = (size_t)HALF * K * 2;
    const size_t tstep = 2 * hstep;
    const unsigned ldsw = (unsigned)wid * 1024u;
    const int aoff = lds_byte(wr * 64 + fr, fq * 8), boff = lds_byte(wc * 32 + fr, fq * 8);
#define PG8_SA(b, h) (((b) * 2 + (h)) * HTB)
#define PG8_SB(b, h) ((4 + (b) * 2 + (h)) * HTB)
#define PG8_STAGE(bufoff, gbase, voff) do { _Pragma("unroll") for (int _i = 0; _i < 2; ++_i) \
        __builtin_amdgcn_global_load_lds((const unsigned*)((const char*)(gbase) + (voff)[_i]), (PG8_LAS unsigned*)(lds + (bufoff) + ldsw + _i * 8192), 16, 0, 0); } while (0)
#define PG8_LDA(dst, b, h) do { _Pragma("unroll") for (int m = 0; m < 4; ++m) _Pragma("unroll") for (int k = 0; k < 2; ++k) dst[m][k] = *(const PG8_LAS bf16x8*)(lds + PG8_SA(b, h) + aoff + m * 2048 + k * 1024); } while (0)
#define PG8_LDB(dst, b, h) do { _Pragma("unroll") for (int n = 0; n < 2; ++n) _Pragma("unroll") for (int k = 0; k < 2; ++k) dst[n][k] = *(const PG8_LAS bf16x8*)(lds + PG8_SB(b, h) + boff + n * 2048 + k * 1024); } while (0)
#define PG8_MMA(ai, bj, At, Bt) do { __builtin_amdgcn_s_setprio(1); _Pragma("unroll") for (int m = 0; m < 4; ++m) _Pragma("unroll") for (int n = 0; n < 2; ++n) _Pragma("unroll") for (int k = 0; k < 2; ++k) \
        acc[ai][bj][m][n] = __builtin_amdgcn_mfma_f32_16x16x32_bf16(Bt[n][k], At[m][k], acc[ai][bj][m][n], 0, 0, 0); __builtin_amdgcn_s_setprio(0); } while (0)
#define PG8_WAIT_V(n) asm volatile("s_waitcnt vmcnt(" #n ")" ::: "memory")
#define PG8_WAIT_L(n) asm volatile("s_waitcnt lgkmcnt(" #n ")" ::: "memory")
#define PG8_BAR __builtin_amdgcn_s_barrier()
#define PG8_SCHED __builtin_amdgcn_sched_barrier(0)
    Unit cur, nxt; int ui = 0;
    if (!S.next(0, cur)) return;
    f32x4 acc[2][2][4][2];
#pragma unroll
    for (int a = 0; a < 2; ++a)
#pragma unroll
        for (int b = 0; b < 2; ++b)
#pragma unroll
            for (int m = 0; m < 4; ++m)
#pragma unroll
                for (int n = 0; n < 2; ++n) acc[a][b][m][n] = (f32x4){0.f, 0.f, 0.f, 0.f};
    bf16x8 At[4][2], B0[2][2], B1[2][2];
    const char* cA = (const char*)g.A + (size_t)cur.pm * tstep; const char* cB = (const char*)g.Bt + (size_t)cur.pn * tstep;
    S.a_ready(cur);
    PG8_STAGE(PG8_SB(0, 0), cB, voffB); PG8_STAGE(PG8_SA(0, 0), cA, voffA); PG8_STAGE(PG8_SB(0, 1), cB + hstep, voffB); PG8_STAGE(PG8_SA(0, 1), cA + hstep, voffA);
    if (wr == 1) PG8_BAR;
    PG8_WAIT_V(4); PG8_BAR;
    PG8_STAGE(PG8_SB(1, 0), cB + kstep, voffB); PG8_STAGE(PG8_SA(1, 0), cA + kstep, voffA); PG8_STAGE(PG8_SB(1, 1), cB + hstep + kstep, voffB);
    PG8_WAIT_V(6); PG8_BAR;
    PG8_STAMP();
    for (;;) {
        const bool has_next = S.next(ui + 1, nxt);
        const char* nA = has_next ? (const char*)g.A + (size_t)nxt.pm * tstep : cA; const char* nB = has_next ? (const char*)g.Bt + (size_t)nxt.pn * tstep : cB;
        for (int t = 0; t < nt; t += 2) {
            const bool last = (t == nt - 2);
            const char* a1 = cA + (size_t)(t + 1) * kstep;
            const char* a2 = last ? nA : cA + (size_t)(t + 2) * kstep; const char* b2 = last ? nB : cB + (size_t)(t + 2) * kstep;
            const char* a3 = a2 + kstep; const char* b3 = b2 + kstep;
            if (last && has_next) S.a_ready(nxt);
            PG8_LDB(B0, 0, 0); PG8_SCHED; PG8_LDA(At, 0, 0); PG8_STAGE(PG8_SA(1, 1), a1 + hstep, voffA);
            PG8_WAIT_L(8); PG8_BAR; PG8_WAIT_L(0); PG8_MMA(0, 0, At, B0); PG8_BAR; PG8_SCHED;
            PG8_LDB(B1, 0, 1); PG8_STAGE(PG8_SB(0, 0), b2, voffB);
            PG8_BAR; PG8_WAIT_L(0); PG8_MMA(0, 1, At, B1); PG8_BAR;
            PG8_LDA(At, 0, 1); PG8_STAGE(PG8_SA(0, 0), a2, voffA);
            PG8_BAR; PG8_WAIT_L(0); PG8_MMA(1, 0, At, B0); PG8_BAR; PG8_SCHED;
            PG8_STAGE(PG8_SB(0, 1), b2 + hstep, voffB);
            PG8_WAIT_V(6); PG8_BAR; PG8_MMA(1, 1, At, B1); PG8_BAR;
            PG8_LDB(B0, 1, 0); PG8_SCHED; PG8_LDA(At, 1, 0); PG8_STAGE(PG8_SA(0, 1), a2 + hstep, voffA);
            PG8_WAIT_L(8); PG8_BAR; PG8_WAIT_L(0); PG8_MMA(0, 0, At, B0); PG8_BAR; PG8_SCHED;
            PG8_LDB(B1, 1, 1); PG8_STAGE(PG8_SB(1, 0), b3, voffB);
            PG8_BAR; PG8_WAIT_L(0); PG8_MMA(0, 1, At, B1); PG8_BAR;
            PG8_LDA(At, 1, 1); PG8_STAGE(PG8_SA(1, 0), a3, voffA);
            PG8_BAR; PG8_WAIT_L(0); PG8_MMA(1, 0, At, B0); PG8_BAR; PG8_SCHED;
            PG8_STAGE(PG8_SB(1, 1), b3 + hstep, voffB);
            PG8_WAIT_V(6); PG8_BAR; PG8_MMA(1, 1, At, B1); PG8_BAR;
        }
        PG8_STAMP();
        if constexpr (!Epi::AFTER_DRAIN) { E(acc, cur, wr, wc, fr, fq); S.done(cur); }
        PG8_STAMP();
        if (!has_next) break;
#pragma unroll
        for (int a = 0; a < 2; ++a)
#pragma unroll
            for (int b = 0; b < 2; ++b)
#pragma unroll
                for (int m = 0; m < 4; ++m)
#pragma unroll
                    for (int n = 0; n < 2; ++n) acc[a][b][m][n] = (f32x4){0.f, 0.f, 0.f, 0.f};
        cur = nxt; cA = nA; cB = nB; ++ui;
    }
    PG8_WAIT_V(0);
    if (wr == 0) PG8_BAR;
    PG8_BAR;
    if constexpr (Epi::AFTER_DRAIN) { E.fused(acc, cur, wr, wc, fr, fq, lds, wid, lane); S.done(cur); }
    PG8_STAMP();
    if (STAMP && wid == 0) { stamps[lane] = lane < nts ? (((unsigned long long)(unsigned)ts_hi << 32) | (unsigned)ts_lo) : 0ull;
        if (lane == 62) stamps[62] = rt_entry; if (lane == 63) stamps[63] = (unsigned long long)wall_clock64(); }
#undef PG8_STAMP
#undef PG8_SA
#undef PG8_SB
#undef PG8_STAGE
#undef PG8_LDA
#undef PG8_LDB
#undef PG8_MMA
#undef PG8_WAIT_V
#undef PG8_WAIT_L
#undef PG8_BAR
#undef PG8_SCHED
}
}
__device__ const double INV_REV[128] = {0.15915494309189535,0.14810514021707516,0.13782250260398285,0.1282537675342271,0.11934937021124886,0.11106318702115607,0.10335229661843406,0.096176757598987819,0.089499401608891013,0.083285640817172504,0.077503288755374058,0.072122393595852222,0.067115083005227255,0.062455419769340485,0.058119267441876246,0.054084165320725783,0.050329212104487035,0.04683495762645621,0.04358330210530733,0.040557402390591489,0.037741584717419771,0.035121263518410453,0.032682865872356998,0.030413761198270856,0.028302195830623399,0.02633723213689523,0.024508691862069852,0.022807103406603451,0.02122365276477766,0.019750137869302395,0.018378926105679667,0.01710291477625845,0.015915494309189534,0.014810514021707515,0.013782250260398284,0.012825376753422709,0.011934937021124886,0.011106318702115607,0.010335229661843406,0.0096176757598987819,0.0089499401608891024,0.0083285640817172511,0.0077503288755374055,0.0072122393595852232,0.0067115083005227253,0.0062455419769340478,0.0058119267441876241,0.0054084165320725779,0.0050329212104487037,0.0046834957626456213,0.0043583302105307331,0.0040557402390591487,0.0037741584717419772,0.0035121263518410454,0.0032682865872356993,0.0030413761198270859,0.0028302195830623399,0.0026337232136895228,0.0024508691862069852,0.0022807103406603446,0.0021223652764777662,0.0019750137869302396,0.0018378926105679667,0.0017102914776258452,0.0015915494309189536,0.0014810514021707515,0.0013782250260398288,0.0012825376753422709,0.0011934937021124885,0.0011106318702115607,0.0010335229661843405,0.00096176757598987806,0.00089499401608891024,0.00083285640817172503,0.00077503288755374051,0.00072122393595852228,0.0006711508300522726,0.00062455419769340487,0.00058119267441876239,0.00054084165320725773,0.00050329212104487033,0.00046834957626456218,0.00043583302105307329,0.00040557402390591486,0.00037741584717419774,0.00035121263518410453,0.00032682865872356992,0.0003041376119827086,0.00028302195830623395,0.00026337232136895234,0.00024508691862069854,0.00022807103406603446,0.00021223652764777661,0.00019750137869302395,0.00018378926105679666,0.00017102914776258454,0.00015915494309189535,0.00014810514021707514,0.00013782250260398286,0.00012825376753422709,0.00011934937021124886,0.00011106318702115607,0.00010335229661843406,9.6176757598987812e-05,8.9499401608891018e-05,8.3285640817172505e-05,7.7503288755374056e-05,7.2122393595852225e-05,6.7115083005227254e-05,6.2455419769340487e-05,5.8119267441876239e-05,5.4084165320725784e-05,5.0329212104487035e-05,4.6834957626456207e-05,4.3583302105307322e-05,4.0557402390591481e-05,3.7741584717419777e-05,3.5121263518410453e-05,3.2682865872356999e-05,3.0413761198270857e-05,2.8302195830623396e-05,2.6337232136895232e-05,2.4508691862069852e-05,2.2807103406603447e-05,2.1223652764777659e-05,1.9750137869302396e-05,1.8378926105679668e-05,1.7102914776258452e-05};

using pg8::bf16_t; using pg8::bf16x8; using pg8::f32x4; using pg8::u32x4; using pg8::Unit;
#define LAS __attribute__((address_space(3)))
typedef float f32x16 __attribute__((ext_vector_type(16)));
typedef short s16x4 __attribute__((ext_vector_type(4)));
typedef unsigned u32x2 __attribute__((ext_vector_type(2)));
typedef float f32x2 __attribute__((ext_vector_type(2)));

constexpr int DM = 1024, NB = 8, SEQ = 4096, LP = 4160, NPAD = 48, NROW = NB * LP;
constexpr int NREAL = NB * SEQ;
constexpr int DIN = 12288, DEPTH = 4, NA = 10240, NG = 2048, NCH = 65;
constexpr int LDS_BIAS = 131072 + 16, LDS_BYTES = LDS_BIAS + 12288 * 2;
constexpr size_t SZ1 = (size_t)NROW * 1024 * 2;
constexpr size_t WS_XN = 0, WS_U = SZ1, WS_MG = 2 * SZ1, WS_Q = 3 * SZ1, WS_K = 4 * SZ1, WS_VH = 5 * SZ1, WS_SZ = 7 * SZ1;
constexpr size_t WS_WIN = 9 * SZ1, WS_WCO = WS_WIN + (size_t)DIN * 1024 * 2, WS_WRO = WS_WCO + 1024 * 1024 * 2, WS_WO = WS_WRO + 1024 * 2048 * 2;
constexpr size_t WS_BP = WS_WO + 1024 * 1024 * 2, WS_ROPE = WS_BP + DIN * 4, WS_GA = WS_ROPE + 2 * (size_t)4112 * 128 * 4, WS_GB = WS_GA + SZ1;
constexpr size_t WS_STAT = WS_GB + SZ1, WS_HMETA = WS_STAT + 4096, WS_BAR = WS_HMETA + 8 * 16 * 1024 * 4, WS_END = WS_BAR + 16384;

struct Params { const float* x; const float* meta; const float* pre_g; const float* w_in; const float* b_in; const float* conv_w; const float* conv_b;
                const float* w_co; const float* gn_g; const float* w_ro; const float* w_o; const float* post_g; float* out; unsigned char* ws; };

__device__ __forceinline__ void row_bp(int r, int& b, int& p) { if (r < NREAL) { b = r >> 12; p = 64 + (r & 4095); } else { const int rr = r - NREAL; b = rr >> 6; p = rr & 63; } }
__device__ __forceinline__ int bp_row(int b, int p) { return p >= 64 ? (b << 12) + (p - 64) : NREAL + (b << 6) + p; }
__device__ __forceinline__ float bflo(unsigned u) { return __uint_as_float(u << 16); }
__device__ __forceinline__ float bfhi(unsigned u) { return __uint_as_float(u & 0xffff0000u); }
typedef __bf16 bf16x2_t __attribute__((ext_vector_type(2)));
__device__ __forceinline__ unsigned pk(float lo, float hi) { typedef float f2_t __attribute__((ext_vector_type(2))); const bf16x2_t v = __builtin_convertvector((f2_t){lo, hi}, bf16x2_t); return __builtin_bit_cast(unsigned, v); }
__device__ __forceinline__ void unpack8(const u32x4 r, float (&f)[8]) { f[0] = bflo(r.x); f[1] = bfhi(r.x); f[2] = bflo(r.y); f[3] = bfhi(r.y); f[4] = bflo(r.z); f[5] = bfhi(r.z); f[6] = bflo(r.w); f[7] = bfhi(r.w); }
__device__ __forceinline__ u32x4 pack8(const float (&f)[8]) { u32x4 r; r.x = pk(f[0], f[1]); r.y = pk(f[2], f[3]); r.z = pk(f[4], f[5]); r.w = pk(f[6], f[7]); return r; }
__device__ __forceinline__ float ex2(float x) { return __builtin_amdgcn_exp2f(x); }
__device__ __forceinline__ float silu_f(float y) { return y * __builtin_amdgcn_rcpf(1.0f + ex2(-1.4426950408889634f * y)); }
__device__ __forceinline__ float sigm_f(float y) { return __builtin_amdgcn_rcpf(1.0f + ex2(-1.4426950408889634f * y)); }
__device__ __forceinline__ float lg_gamma(int hd) { return hd == 0 ? -0.0458036896131f : hd == 1 ? -0.0227200765001f : hd == 2 ? -0.0113153132278f : -0.00564656314114f; }
__device__ __forceinline__ float wave_sum(float v) { for (int o = 32; o >= 1; o >>= 1) v += __shfl_xor(v, o); return v; }
#define LBAR() do { asm volatile("s_waitcnt lgkmcnt(0)" ::: "memory"); __builtin_amdgcn_s_barrier(); asm volatile("" ::: "memory"); } while (0)

struct EpiIn {
    static constexpr bool PERM = true, AFTER_DRAIN = false;
    bf16_t *U, *MG, *Q, *K, *VH, *SZ, *GA, *GB; const LAS bf16_t* bperm; const float* ct; const float* st;
    __device__ __forceinline__ void operator()(const f32x4 (&acc)[2][2][4][2], const Unit& u, int wr, int wc, int fr, int fq) const {
        const int pn = u.pn, cc = wc * 32 + 8 * fq;
        float irv[8];
#pragma unroll
        for (int e = 0; e < 8; ++e) irv[e] = (pn >= 16 && pn < 24) ? ex2(-0.10381025296523007f * (float)(cc + e) - 2.651496129472319f) : 0.f;
        f32x4 bv[2][2];
#pragma unroll
        for (int bj = 0; bj < 2; ++bj)
#pragma unroll
            for (int n = 0; n < 2; ++n) { const u32x2 raw = *(const LAS u32x2*)(bperm + pn * 256 + bj * 128 + cc + 4 * n); bv[bj][n] = (f32x4){bflo(raw.x), bfhi(raw.x), bflo(raw.y), bfhi(raw.y)}; }
#pragma unroll
        for (int ai = 0; ai < 2; ++ai)
#pragma unroll
            for (int m = 0; m < 4; ++m) {
                const int r = u.pm * 256 + ai * 128 + wr * 64 + m * 16 + fr; int b, p; row_bp(r, b, p);
                float x[8], y[8], o1[8], o2[8];
#pragma unroll
                for (int n = 0; n < 2; ++n)
#pragma unroll
                    for (int j = 0; j < 4; ++j) { x[4 * n + j] = acc[ai][0][m][n][j] + bv[0][n][j]; y[4 * n + j] = acc[ai][1][m][n][j] + bv[1][n][j]; }
                if (pn < 8) {
#pragma unroll
                    for (int e = 0; e < 8; ++e) o1[e] = x[e] * y[e];
                    *(u32x4*)(U + (size_t)r * 1024 + pn * 128 + cc) = pack8(o1);
                } else if (pn < 16) {
#pragma unroll
                    for (int e = 0; e < 8; ++e) o1[e] = x[e] * silu_f(y[e]);
                    *(u32x4*)(MG + (size_t)r * 1024 + (pn - 8) * 128 + cc) = pack8(o1);
                } else if (pn < 24) {
                    const bool isk = pn >= 20; const int hd = isk ? pn - 20 : pn - 16; const float sc = isk ? 0.0625f : 1.0f;
                    if (p >= NPAD) {
                        const float posf = (float)(p - NPAD);
#pragma unroll
                        for (int e = 0; e < 8; ++e) { const float fr_ = __builtin_amdgcn_fractf(posf * irv[e]); const float c = __builtin_amdgcn_cosf(fr_), s = __builtin_amdgcn_sinf(fr_);
                            o1[e] = (x[e] * c - y[e] * s) * sc; o2[e] = (x[e] * s + y[e] * c) * sc; }
                    } else {
#pragma unroll
                        for (int e = 0; e < 8; ++e) { o1[e] = 0.f; o2[e] = 0.f; }
                    }
                    bf16_t* dst = (isk ? K : Q) + (size_t)((b * 4 + hd) * LP + p) * 256 + cc;
                    *(u32x4*)dst = pack8(o1); *(u32x4*)(dst + 128) = pack8(o2);
                } else if (pn < 32) {
                    const int vt = pn - 24; const float dec = (p >= NPAD) ? ex2(lg_gamma(vt >> 1) * (float)(63 - (p & 63))) : 0.f;
#pragma unroll
                    for (int e = 0; e < 8; ++e) { o1[e] = x[e] * dec; o2[e] = y[e] * dec; }
                    const int ch1 = (vt & 1) * 256 + cc, ch2 = ch1 + 128, bh8 = (b * 4 + (vt >> 1)) * 8;
                    *(u32x4*)(VH + (size_t)((bh8 + (ch1 >> 6)) * LP + p) * 64 + (ch1 & 63)) = pack8(o1);
                    *(u32x4*)(VH + (size_t)((bh8 + (ch2 >> 6)) * LP + p) * 64 + (ch2 & 63)) = pack8(o2);
                } else if (pn < 40) {
#pragma unroll
                    for (int e = 0; e < 8; ++e) { o1[e] = x[e]; o2[e] = y[e]; }
                    bf16_t* dst = SZ + (size_t)r * 2048 + (pn - 32) * 256 + cc;
                    *(u32x4*)dst = pack8(o1); *(u32x4*)(dst + 128) = pack8(o2);
                } else {
#pragma unroll
                    for (int e = 0; e < 8; ++e) { o1[e] = x[e]; o2[e] = y[e]; }
                    bf16_t* dst = (pn < 44 ? GA : GB) + (size_t)r * 1024 + (pn & 3) * 256 + cc;
                    *(u32x4*)dst = pack8(o1); *(u32x4*)(dst + 128) = pack8(o2);
                }
            }
    }
};
template <int MODE> struct EpiOut {
    static constexpr bool PERM = true, AFTER_DRAIN = false;
    const bf16_t* G; bf16_t* Y; bf16_t* Y2; const float* bias;
    __device__ __forceinline__ void operator()(const f32x4 (&acc)[2][2][4][2], const Unit& u, int wr, int wc, int fr, int fq) const {
        const int cc = wc * 32 + 8 * fq;
#pragma unroll
        for (int ai = 0; ai < 2; ++ai) {
            u32x4 gq[4][2], yq[4][2];
            if (MODE == 1 || MODE == 2) {
#pragma unroll
                for (int m = 0; m < 4; ++m)
#pragma unroll
                    for (int bj = 0; bj < 2; ++bj) { const size_t off = (size_t)(u.pm * 256 + ai * 128 + wr * 64 + m * 16 + fr) * 1024 + u.pn * 256 + bj * 128 + cc;
                        gq[m][bj] = __builtin_nontemporal_load((const u32x4*)(G + off)); if (MODE == 2) yq[m][bj] = *(const u32x4*)(Y + off); }
                __builtin_amdgcn_sched_barrier(0);
            }
#pragma unroll
            for (int m = 0; m < 4; ++m) {
                const int r = u.pm * 256 + ai * 128 + wr * 64 + m * 16 + fr;
#pragma unroll
                for (int bj = 0; bj < 2; ++bj) {
                    float v[8], o[8];
#pragma unroll
                    for (int n = 0; n < 2; ++n)
#pragma unroll
                        for (int j = 0; j < 4; ++j) v[4 * n + j] = acc[ai][bj][m][n][j];
                    if (MODE == 0) {
                        const int c = u.pn * 256 + bj * 128 + cc;
                        const f32x4 b0 = *(const f32x4*)(bias + c), b1 = *(const f32x4*)(bias + c + 4);
#pragma unroll
                        for (int e = 0; e < 8; ++e) o[e] = sigm_f(v[e] + (e < 4 ? b0[e & 3] : b1[e & 3]));
                        bf16_t* dst = (u.pn < 4 ? Y : Y2) + (size_t)r * 1024 + (u.pn & 3) * 256 + bj * 128 + cc;
                        *(u32x4*)dst = pack8(o);
                    } else {
                        const size_t off = (size_t)r * 1024 + u.pn * 256 + bj * 128 + cc;
                        if (MODE == 3) {
#pragma unroll
                            for (int e = 0; e < 8; ++e) o[e] = v[e];
                        } else {
                            float g[8]; unpack8(gq[m][bj], g);
#pragma unroll
                            for (int e = 0; e < 8; ++e) g[e] = sigm_f(g[e]);
                            if (MODE == 1) {
#pragma unroll
                                for (int e = 0; e < 8; ++e) o[e] = g[e] * v[e];
                            } else {
                                float yv[8]; unpack8(yq[m][bj], yv);
#pragma unroll
                                for (int e = 0; e < 8; ++e) o[e] = yv[e] + g[e] * v[e];
                            }
                        }
                        *(u32x4*)(Y + off) = pack8(o);
                    }
                }
            }
        }
    }
};

template <int MODE> __device__ __forceinline__ void meta_gemm(const bf16_t* A, const bf16_t* Bt, int K, int N, const bf16_t* G, bf16_t* Y, bf16_t* Y2, const float* bias) {
    int tid_l = threadIdx.x; asm volatile("" : "+v"(tid_l));
    const int lane = tid_l & 63, wv = tid_l >> 6, lr = lane & 15, g = lane >> 4;
    const int ntile = 8 * (N >> 4);
    for (int t = blockIdx.x * 8 + wv; t < ntile; t += gridDim.x * 8) {
        const int bt = t & 7, ct = t >> 3, row0 = NREAL + bt * 64 + NPAD;
        const bf16_t* ap = A + (size_t)(row0 + lr) * K + 8 * g; const bf16_t* bp = Bt + (size_t)(16 * ct + lr) * K + 8 * g;
        f32x4 acc = (f32x4){0.f, 0.f, 0.f, 0.f};
        for (int kb = 0; kb < K / 32; kb += 16) {
            bf16x8 af[16], bfr[16];
#pragma unroll
            for (int i = 0; i < 16; ++i) { af[i] = *(const bf16x8*)(ap + 32 * (kb + i)); bfr[i] = *(const bf16x8*)(bp + 32 * (kb + i)); }
            __builtin_amdgcn_sched_barrier(0);
#pragma unroll
            for (int i = 0; i < 16; ++i) acc = __builtin_amdgcn_mfma_f32_16x16x32_bf16(af[i], bfr[i], acc, 0, 0, 0);
            __builtin_amdgcn_sched_barrier(0);
        }
        const int col = 16 * ct + lr;
#pragma unroll
        for (int rg = 0; rg < 4; ++rg) {
            const int row = row0 + 4 * g + rg; const float v = acc[rg]; float o;
            if (MODE == 0) { o = sigm_f(v + bias[col]); (col < 1024 ? Y : Y2)[(size_t)row * 1024 + (col & 1023)] = (bf16_t)(pk(o, 0.f) & 0xffffu); }
            else { const size_t off = (size_t)row * 1024 + col;
                if (MODE == 3) o = v; else { const float gv = sigm_f(bflo((unsigned)G[off])); o = gv * v; if (MODE == 2) o += bflo((unsigned)Y[off]); }
                Y[off] = (bf16_t)(pk(o, 0.f) & 0xffffu); }
        }
    }
}

__device__ __forceinline__ int dest_of_orig(int n) {
    if (n >= 4096) return n;
    const int grp = n >> 10, j = n & 1023, t = j >> 7, cc = j & 127;
    const int tile = (grp == 0 || grp == 2) ? t : 8 + t, half = (grp >= 2) ? 1 : 0;
    return tile * 256 + half * 128 + cc;
}
__device__ __forceinline__ void convert_phase(LAS unsigned char* lds, const Params& P, int l) {
    int tid_l = threadIdx.x; asm volatile("" : "+v"(tid_l));
    const int tid = tid_l; LAS float* T = (LAS float*)lds;
    unsigned char* ws = P.ws;
    for (int t4 = blockIdx.x * 4; t4 < 4096; t4 += gridDim.x * 4) {
        const int k0 = tid >> 4, n4 = (tid & 15) * 4;
        f32x4 ld[4][2];
#pragma unroll
        for (int q = 0; q < 4; ++q) {
            const int t = t4 + q; const float* src; int N, kb, nb;
            if (t < 3072) { src = P.w_in + (size_t)l * 1024 * DIN; N = DIN; kb = t / 192; nb = t % 192; }
            else if (t < 3328) { const int u = t - 3072; src = P.w_co + (size_t)l * 1024 * 1024; N = 1024; kb = u >> 4; nb = u & 15; }
            else if (t < 3840) { const int u = t - 3328; src = P.w_ro + (size_t)l * 2048 * 1024; N = 1024; kb = u >> 4; nb = u & 15; }
            else { const int u = t - 3840; src = P.w_o + (size_t)l * 1024 * 1024; N = 1024; kb = u >> 4; nb = u & 15; }
#pragma unroll
            for (int i = 0; i < 2; ++i) ld[q][i] = __builtin_nontemporal_load((const f32x4*)(src + (size_t)(kb * 64 + k0 + 32 * i) * N + nb * 64 + n4));
            if (t < 3072 && kb == 0 && tid < 64) ((float*)(ws + WS_BP))[dest_of_orig(nb * 64 + tid)] = P.b_in[(size_t)l * DIN + nb * 64 + tid];
        }
#pragma unroll
        for (int q = 0; q < 4; ++q)
#pragma unroll
            for (int i = 0; i < 2; ++i)
#pragma unroll
                for (int j = 0; j < 4; ++j) T[q * 4160 + (n4 + j) * 65 + k0 + 32 * i] = ld[q][i][j];
        __syncthreads();
#pragma unroll
        for (int q = 0; q < 4; ++q) {
            const int t = t4 + q; bf16_t* dst; int K, kb, nb; bool perm = false;
            if (t < 3072) { dst = (bf16_t*)(ws + WS_WIN); K = 1024; kb = t / 192; nb = t % 192; perm = true; }
            else if (t < 3328) { const int u = t - 3072; dst = (bf16_t*)(ws + WS_WCO); K = 1024; kb = u >> 4; nb = u & 15; }
            else if (t < 3840) { const int u = t - 3328; dst = (bf16_t*)(ws + WS_WRO); K = 2048; kb = u >> 4; nb = u & 15; }
            else { const int u = t - 3840; dst = (bf16_t*)(ws + WS_WO); K = 1024; kb = u >> 4; nb = u & 15; }
            const int n = tid >> 3, kc = (tid & 7) * 8; float f[8];
#pragma unroll
            for (int j = 0; j < 8; ++j) f[j] = T[q * 4160 + n * 65 + kc + j];
            const int drow = perm ? dest_of_orig(nb * 64 + n) : nb * 64 + n;
            *(u32x4*)(dst + (size_t)drow * K + kb * 64 + kc) = pack8(f);
        }
        __syncthreads();
    }
}

__device__ __forceinline__ void norm_phase(const Params& P, int l) {
    int tid_l = threadIdx.x; asm volatile("" : "+v"(tid_l));
    const int tid = tid_l, lane = tid & 63, wv = tid >> 6;
    bf16_t* XN = (bf16_t*)(P.ws + WS_XN); float* HMETA = (float*)(P.ws + WS_HMETA);
    for (int row = blockIdx.x * 8 + wv; row < NROW; row += gridDim.x * 8) {
        int b, p; row_bp(row, b, p);
        bf16_t* xr = XN + (size_t)row * 1024;
        if (l == DEPTH && p < 64) continue;
        if (p < NPAD) {
            if (l == 0) {
#pragma unroll
                for (int k = 0; k < 4; ++k) *(u32x2*)(xr + 256 * k + 4 * lane) = (u32x2){0u, 0u};
            }
            continue;
        }
        float* hp = p >= 64 ? P.out + (size_t)(b * SEQ + p - 64) * 1024 : HMETA + (size_t)(b * 16 + p - NPAD) * 1024;
        f32x4 v[4];
        if (l == 0) {
            const float* src = p >= 64 ? P.x + (size_t)(b * SEQ + p - 64) * 1024 : P.meta + (size_t)(p - NPAD) * 1024;
#pragma unroll
            for (int k = 0; k < 4; ++k) v[k] = __builtin_nontemporal_load((const f32x4*)(src + 256 * k + 4 * lane));
        } else {
            f32x4 o[4], hv[4]; float ss = 0.f;
            const float* hsrc = (l == 1 && p >= 64) ? P.x + (size_t)(b * SEQ + p - 64) * 1024 : hp;
#pragma unroll
            for (int k = 0; k < 4; ++k) hv[k] = __builtin_nontemporal_load((const f32x4*)(hsrc + 256 * k + 4 * lane));
#pragma unroll
            for (int k = 0; k < 4; ++k) { const u32x2 raw = __builtin_nontemporal_load((const u32x2*)(xr + 256 * k + 4 * lane)); o[k] = (f32x4){bflo(raw.x), bfhi(raw.x), bflo(raw.y), bfhi(raw.y)};
                ss += o[k][0] * o[k][0] + o[k][1] * o[k][1] + o[k][2] * o[k][2] + o[k][3] * o[k][3]; }
            ss = wave_sum(ss); const float rs = rsqrtf(ss * (1.0f / 1024.0f) + 1e-6f);
#pragma unroll
            for (int k = 0; k < 4; ++k) { const f32x4 g = *(const f32x4*)(P.post_g + (size_t)(l - 1) * 1024 + 256 * k + 4 * lane);
                v[k] = hv[k] + o[k] * rs * g; }
        }
        if (l != 0 || p < 64) {
#pragma unroll
            for (int k = 0; k < 4; ++k) __builtin_nontemporal_store(v[k], (f32x4*)(hp + 256 * k + 4 * lane));
        }
        if (l == DEPTH) continue;
        float s2 = 0.f;
#pragma unroll
        for (int k = 0; k < 4; ++k) s2 += v[k][0] * v[k][0] + v[k][1] * v[k][1] + v[k][2] * v[k][2] + v[k][3] * v[k][3];
        s2 = wave_sum(s2); const float r2 = rsqrtf(s2 * (1.0f / 1024.0f) + 1e-6f);
#pragma unroll
        for (int k = 0; k < 4; ++k) { const f32x4 g = *(const f32x4*)(P.pre_g + (size_t)l * 1024 + 256 * k + 4 * lane); const f32x4 y = v[k] * r2 * g;
            *(u32x2*)(xr + 256 * k + 4 * lane) = (u32x2){pk(y[0], y[1]), pk(y[2], y[3])}; }
    }
}

__device__ __forceinline__ bf16x8 tr2(LAS unsigned char* a0, LAS unsigned char* a1) {
    const s16x4 t0 = __builtin_amdgcn_ds_read_tr16_b64_v4i16((LAS s16x4*)a0), t1 = __builtin_amdgcn_ds_read_tr16_b64_v4i16((LAS s16x4*)a1);
    return __builtin_shufflevector(t0, t1, 0, 1, 2, 3, 4, 5, 6, 7);
}
__device__ __forceinline__ void scan_phase(LAS unsigned char* lds, const Params& P) {
    constexpr int QP = 528, VP = 144, OFF_Q = 0, OFF_K = 64 * QP, OFF_SB = 2 * 64 * QP, OFF_V = 3 * 64 * QP, OFF_P = OFF_V + 64 * VP, OFF_O = OFF_P + 64 * VP;
    static_assert(OFF_O + 64 * VP <= 131072, "scan LDS");
    int tid_l = threadIdx.x; asm volatile("" : "+v"(tid_l));
    const int tid = tid_l, lane = tid & 63, w = __builtin_amdgcn_readfirstlane(tid >> 6);
    const bf16_t* Q = (const bf16_t*)(P.ws + WS_Q); const bf16_t* K = (const bf16_t*)(P.ws + WS_K); bf16_t* VH = (bf16_t*)(P.ws + WS_VH);
    float2* STAT = (float2*)(P.ws + WS_STAT);
    const int mb = w >> 1, nb0 = 2 * (w & 1), rb = w >> 1, cb0 = 2 * (w & 1);
    for (int cidx = blockIdx.x; cidx < 256; cidx += gridDim.x) {
        const int chain = (cidx & 7) * 32 + (cidx >> 3);
        const int b = chain >> 5, hd = (chain >> 3) & 3, sl = chain & 7; const float lg = lg_gamma(hd);
        f32x16 S[2];
#pragma unroll
        for (int i = 0; i < 16; ++i) { S[0][i] = 0.f; S[1][i] = 0.f; }
        for (int i = tid; i < 64 * QP / 16; i += 512) *(LAS u32x4*)(lds + OFF_SB + 16 * i) = (u32x4){0u, 0u, 0u, 0u};
        u32x4 qr[4], kr[4], vr;
#define SCAN_LOADQ(ci_) do { const bf16_t* qb_ = Q + (size_t)((b * 4 + hd) * LP + 64 * (ci_)) * 256; _Pragma("unroll") for (int i = 0; i < 4; ++i) qr[i] = *(const u32x4*)(qb_ + (tid + 512 * i) * 8); } while (0)
#define SCAN_LOADK(ci_) do { const bf16_t* kb_ = K + (size_t)((b * 4 + hd) * LP + 64 * (ci_)) * 256; _Pragma("unroll") for (int i = 0; i < 4; ++i) kr[i] = *(const u32x4*)(kb_ + (tid + 512 * i) * 8); } while (0)
#define SCAN_VPTR(ci_) (VH + (size_t)(((b * 4 + hd) * 8 + sl) * LP + 64 * (ci_)) * 64 + tid * 8)
#define SCAN_LOADV(ci_) do { vr = __builtin_nontemporal_load((const u32x4*)SCAN_VPTR(ci_)); } while (0)
#define SCAN_LOAD(ci_) do { SCAN_LOADQ(ci_); SCAN_LOADK(ci_); SCAN_LOADV(ci_); } while (0)
#define SCAN_STORE() do { _Pragma("unroll") for (int i = 0; i < 4; ++i) { const int id = tid + 512 * i, row = id >> 5, ch = id & 31; \
            *(LAS u32x4*)(lds + OFF_Q + row * QP + ch * 16) = qr[i]; *(LAS u32x4*)(lds + OFF_K + row * QP + ch * 16) = kr[i]; } \
            *(LAS u32x4*)(lds + OFF_V + (tid >> 3) * VP + (tid & 7) * 16) = vr; } while (0)
        SCAN_LOAD(0); SCAN_STORE(); LBAR();
        for (int ci = 0; ci < NCH; ++ci) {
            int lane_v = lane; asm volatile("" : "+v"(lane_v));
            const int lr = lane_v & 15, g = lane_v >> 4, l31 = lane_v & 31, hh = lane_v >> 5, blk = (lane_v >> 4) & 1, q4 = (lane_v & 15) >> 2, p4 = lane_v & 3;
            if (ci > 0) __builtin_nontemporal_store(*(const LAS u32x4*)(lds + OFF_O + (tid >> 3) * VP + (tid & 7) * 16), (u32x4*)SCAN_VPTR(ci - 1));
            if (ci + 1 < NCH) SCAN_LOADQ(ci + 1);
            float ov[4][2];
            bf16x8 qf[8];
            {
                f32x4 accP[2] = {(f32x4){0.f, 0.f, 0.f, 0.f}, (f32x4){0.f, 0.f, 0.f, 0.f}};
#pragma unroll
                for (int hb = 0; hb < 2; ++hb) {
                    bf16x8 kf[2][4];
#pragma unroll
                    for (int k4 = 0; k4 < 4; ++k4) { const int ks = 4 * hb + k4;
                        qf[ks] = *(const LAS bf16x8*)(lds + OFF_Q + (16 * rb + lr) * QP + (32 * ks + 8 * g) * 2);
#pragma unroll
                        for (int t = 0; t < 2; ++t) kf[t][k4] = *(const LAS bf16x8*)(lds + OFF_K + (16 * (cb0 + t) + lr) * QP + (32 * ks + 8 * g) * 2); }
                    __builtin_amdgcn_sched_barrier(0);
#pragma unroll
                    for (int k4 = 0; k4 < 4; ++k4)
#pragma unroll
                        for (int t = 0; t < 2; ++t) accP[t] = __builtin_amdgcn_mfma_f32_16x16x32_bf16(kf[t][k4], qf[4 * hb + k4], accP[t], 0, 0, 0);
                    __builtin_amdgcn_sched_barrier(0);
                }
                const int n = 16 * rb + lr;
#pragma unroll
                for (int t = 0; t < 2; ++t) { float pv[4];
#pragma unroll
                    for (int rg = 0; rg < 4; ++rg) { const int m = 16 * (cb0 + t) + 4 * g + rg, d = m - n; pv[rg] = accP[t][rg] * ex2(lg * (float)(-64 + (d > 0 ? 2 * d : 0))); }
                    *(LAS u32x2*)(lds + OFF_P + n * VP + (16 * (cb0 + t) + 4 * g) * 2) = (u32x2){pk(pv[0], pv[1]), pk(pv[2], pv[3])}; }
            }
            LBAR();
            if (ci + 1 < NCH) SCAN_LOADK(ci + 1);
            {
                f32x4 accO[2] = {(f32x4){0.f, 0.f, 0.f, 0.f}, (f32x4){0.f, 0.f, 0.f, 0.f}};
                bf16x8 pf[2], vf[2][2];
#pragma unroll
                for (int hb = 0; hb < 2; ++hb) {
                    bf16x8 sf[2][4];
#pragma unroll
                    for (int k4 = 0; k4 < 4; ++k4)
#pragma unroll
                        for (int t = 0; t < 2; ++t) sf[t][k4] = *(const LAS bf16x8*)(lds + OFF_SB + (16 * (cb0 + t) + lr) * QP + (32 * (4 * hb + k4) + 8 * g) * 2);
                    if (hb == 1) {
#pragma unroll
                        for (int ks = 0; ks < 2; ++ks) {
                            pf[ks] = *(const LAS bf16x8*)(lds + OFF_P + (16 * rb + lr) * VP + (32 * ks + 8 * g) * 2);
#pragma unroll
                            for (int t = 0; t < 2; ++t) { LAS unsigned char* base = lds + OFF_V + (32 * ks + 8 * g + q4) * VP + (16 * (cb0 + t) + 4 * p4) * 2; vf[t][ks] = tr2(base, base + 4 * VP); }
                        }
                    }
                    __builtin_amdgcn_sched_barrier(0);
#pragma unroll
                    for (int k4 = 0; k4 < 4; ++k4)
#pragma unroll
                        for (int t = 0; t < 2; ++t) accO[t] = __builtin_amdgcn_mfma_f32_16x16x32_bf16(qf[4 * hb + k4], sf[t][k4], accO[t], 0, 0, 0);
                    __builtin_amdgcn_sched_barrier(0);
                }
#pragma unroll
                for (int ks = 0; ks < 2; ++ks)
#pragma unroll
                    for (int t = 0; t < 2; ++t) accO[t] = __builtin_amdgcn_mfma_f32_16x16x32_bf16(pf[ks], vf[t][ks], accO[t], 0, 0, 0);
#pragma unroll
                for (int rg = 0; rg < 4; ++rg) { const float sc = ex2(lg * (float)(16 * rb + 4 * g + rg + 1)); ov[rg][0] = accO[0][rg] * sc; ov[rg][1] = accO[1][rg] * sc; }
            }
            if (ci + 1 < NCH) SCAN_LOADV(ci + 1);
            {
                bf16x8 af[4], bf[2][4];
#pragma unroll
                for (int ks = 0; ks < 4; ++ks) {
                    LAS unsigned char* ab = lds + OFF_K + (16 * ks + 8 * hh + q4) * QP + (32 * w + 16 * blk + 4 * p4) * 2;
                    af[ks] = tr2(ab, ab + 4 * QP);
#pragma unroll
                    for (int tv = 0; tv < 2; ++tv) { LAS unsigned char* bb = lds + OFF_V + (16 * ks + 8 * hh + q4) * VP + (32 * tv + 16 * blk + 4 * p4) * 2; bf[tv][ks] = tr2(bb, bb + 4 * VP); }
                }
                const float cd = ex2(lg * 64.0f);
                S[0] *= cd; S[1] *= cd;
                __builtin_amdgcn_sched_barrier(0);
#pragma unroll
                for (int ks = 0; ks < 4; ++ks)
#pragma unroll
                    for (int tv = 0; tv < 2; ++tv) S[tv] = __builtin_amdgcn_mfma_f32_32x32x16_bf16(af[ks], bf[tv][ks], S[tv], 0, 0, 0);
            }
            LBAR();
#pragma unroll
            for (int tv = 0; tv < 2; ++tv)
#pragma unroll
                for (int rg = 0; rg < 4; ++rg)
                    *(LAS u32x2*)(lds + OFF_SB + (32 * tv + l31) * QP + (32 * w + 8 * rg + 4 * hh) * 2) = (u32x2){pk(S[tv][4 * rg], S[tv][4 * rg + 1]), pk(S[tv][4 * rg + 2], S[tv][4 * rg + 3])};
#pragma unroll
            for (int rg = 0; rg < 4; ++rg)
#pragma unroll
                for (int t = 0; t < 2; ++t) *(LAS bf16_t*)(lds + OFF_O + (16 * rb + 4 * g + rg) * VP + (16 * (cb0 + t) + lr) * 2) = (bf16_t)(pk(ov[rg][t], 0.f) & 0xffffu);
            if (ci + 1 < NCH) SCAN_STORE();
            LBAR();
        }
        __builtin_nontemporal_store(*(const LAS u32x4*)(lds + OFF_O + (tid >> 3) * VP + (tid & 7) * 16), (u32x4*)SCAN_VPTR(NCH - 1));
        LBAR();
#undef SCAN_LOAD
#undef SCAN_STORE
    }
}

__device__ __forceinline__ void elem_phase(LAS unsigned char* lds, const Params& P, int l) {
    int tid_l = threadIdx.x; asm volatile("" : "+v"(tid_l));
    const int tid = tid_l, lane = tid & 63, wv = tid >> 6;
    const bf16_t* U = (const bf16_t*)(P.ws + WS_U); bf16_t* MG = (bf16_t*)(P.ws + WS_MG); const bf16_t* RET = (const bf16_t*)(P.ws + WS_VH); bf16_t* A2 = (bf16_t*)(P.ws + WS_Q); const bf16_t* SZ = (const bf16_t*)(P.ws + WS_SZ);
    const f32x2* STAT = (const f32x2*)(P.ws + WS_STAT);
    f32x4 cw[2][4][2], gg[4][2];
#pragma unroll
    for (int k = 0; k < 2; ++k) { const int c8 = (lane + 64 * k) * 8;
#pragma unroll
        for (int j = 0; j < 3; ++j) { cw[k][j][0] = *(const f32x4*)(P.conv_w + (size_t)l * 3072 + j * 1024 + c8); cw[k][j][1] = *(const f32x4*)(P.conv_w + (size_t)l * 3072 + j * 1024 + c8 + 4); }
        cw[k][3][0] = *(const f32x4*)(P.conv_b + (size_t)l * 1024 + c8); cw[k][3][1] = *(const f32x4*)(P.conv_b + (size_t)l * 1024 + c8 + 4); }
#pragma unroll
    for (int k = 0; k < 4; ++k) { const int c = (lane + 64 * k) * 8; gg[k][0] = *(const f32x4*)(P.gn_g + (size_t)l * 2048 + c); gg[k][1] = *(const f32x4*)(P.gn_g + (size_t)l * 2048 + c + 4); }
    const int vblk = (gridDim.x == 256) ? (int)((blockIdx.x & 7) * 32 + (blockIdx.x >> 3)) : (int)blockIdx.x;
    for (int row = vblk * 8 + wv; row < NROW; row += gridDim.x * 8) {
        int b, p; row_bp(row, b, p);
        if (p < NPAD || (l == DEPTH - 1 && p < 64)) continue;
        const int rm1 = bp_row(b, p - 1 >= NPAD ? p - 1 : NPAD), rm2 = bp_row(b, p - 2 >= NPAD ? p - 2 : NPAD);
        u32x4 ur[2][3], mr[2], rr[4], zr[4];
#pragma unroll
        for (int k = 0; k < 2; ++k) { const int c8 = (lane + 64 * k) * 8;
            ur[k][2] = *(const u32x4*)(U + (size_t)row * 1024 + c8); mr[k] = __builtin_nontemporal_load((const u32x4*)(MG + (size_t)row * 1024 + c8));
            ur[k][1] = (p - 1 >= NPAD) ? *(const u32x4*)(U + (size_t)rm1 * 1024 + c8) : (u32x4){0u, 0u, 0u, 0u};
            ur[k][0] = (p - 2 >= NPAD) ? *(const u32x4*)(U + (size_t)rm2 * 1024 + c8) : (u32x4){0u, 0u, 0u, 0u}; }
#pragma unroll
        for (int k = 0; k < 4; ++k) { const int c = (lane + 64 * k) * 8; rr[k] = __builtin_nontemporal_load((const u32x4*)(RET + (size_t)(((b * 4 + k) * 8 + (lane >> 3)) * LP + p) * 64 + (lane & 7) * 8)); zr[k] = __builtin_nontemporal_load((const u32x4*)(SZ + (size_t)row * 2048 + c)); }
#pragma unroll
        for (int k = 0; k < 2; ++k) { const int c8 = (lane + 64 * k) * 8; float u0[8], u1[8], u2[8], mg[8], o[8];
            unpack8(ur[k][0], u0); unpack8(ur[k][1], u1); unpack8(ur[k][2], u2); unpack8(mr[k], mg);
#pragma unroll
            for (int e = 0; e < 8; ++e) o[e] = mg[e] * (cw[k][3][e >> 2][e & 3] + cw[k][0][e >> 2][e & 3] * u0[e] + cw[k][1][e >> 2][e & 3] * u1[e] + cw[k][2][e >> 2][e & 3] * u2[e]);
            *(u32x4*)(MG + (size_t)row * 1024 + c8) = pack8(o); }
#pragma unroll
        for (int k = 0; k < 4; ++k) { const int c = (lane + 64 * k) * 8;
            float rv[8], sz[8], o[8]; unpack8(rr[k], rv); unpack8(zr[k], sz);
            float s1 = 0.f, s2 = 0.f;
#pragma unroll
            for (int e = 0; e < 8; ++e) { s1 += rv[e]; s2 += rv[e] * rv[e]; }
            s1 = wave_sum(s1); s2 = wave_sum(s2);
            const float mk = s1 * (1.0f / 512.0f); float var = s2 * (1.0f / 512.0f) - mk * mk; var = var > 0.f ? var : 0.f; const float rk = rsqrtf(var + 1e-5f);
#pragma unroll
            for (int e = 0; e < 8; ++e) o[e] = (rv[e] - mk) * rk * gg[k][e >> 2][e & 3] * silu_f(sz[e]);
            *(u32x4*)(A2 + (size_t)row * 2048 + c) = pack8(o); }
    }
    __syncthreads();
}


#define XB_TMO      128
#define XB_XCNT(j)  (256  + 64 * (j))
#define XB_XSUB(j)  (1280 + 64 * (j))
#define XB_XGEN(j)  (2304 + 64 * (j))
#define XB_TOP      3328
#define XB_TOPGEN   3392
#define XCD_BAR_WORDS 3456
#define XB_SPIN_CAP (1u << 18)

__device__ __forceinline__ unsigned xb_ld(unsigned* p)              { return __hip_atomic_load(p, __ATOMIC_RELAXED, __HIP_MEMORY_SCOPE_AGENT); }
__device__ __forceinline__ unsigned xb_add(unsigned* p, unsigned v) { return __hip_atomic_fetch_add(p, v, __ATOMIC_RELAXED, __HIP_MEMORY_SCOPE_AGENT); }
__device__ __forceinline__ unsigned xb_xcc_id() { return (unsigned)__builtin_amdgcn_s_getreg((3 << 11) | 20) & 0xFu; }
#define XB_SPIN(cond, bar) do { unsigned _sp = 0; while (cond) { __builtin_amdgcn_s_sleep(1); \
    if ((++_sp & 255u) == 0u) { if (xb_ld(&(bar)[XB_TMO])) break; if (_sp > XB_SPIN_CAP) { atomicAdd(&(bar)[XB_TMO], 1u); break; } } } } while (0)

struct XcdBarrier {
    unsigned* bar; unsigned x;
    volatile LAS unsigned* st;
};

__device__ __forceinline__ XcdBarrier xcd_barrier_post(unsigned* bar, volatile LAS unsigned* st) {
    XcdBarrier b; b.bar = bar; b.x = xb_xcc_id(); b.st = st;
    if (threadIdx.x == 0) (void)xb_add(&bar[XB_XCNT(b.x)], 1u);
    return b;
}
__device__ __forceinline__ void xcd_barrier_complete(unsigned* bar, unsigned x, unsigned& nloc, unsigned& nx) {
    const unsigned G = gridDim.x * gridDim.y * gridDim.z;
    unsigned sum, cnt, mine, sp = 0u;
    for (;;) {
        sum = 0u; cnt = 0u; mine = 0u;
#pragma unroll
        for (unsigned j = 0; j < 16; ++j) { const unsigned c = xb_ld(&bar[XB_XCNT(j)]); sum += c; cnt += (c > 0u) ? 1u : 0u; mine = (j == x) ? c : mine; }
        if (sum == G) break;
        __builtin_amdgcn_s_sleep(1);
        if ((++sp & 255u) == 0u) { if (xb_ld(&bar[XB_TMO])) break; if (sp > XB_SPIN_CAP) { atomicAdd(&bar[XB_TMO], 1u); break; } }
    }
    nloc = mine > 0u ? mine : 1u; nx = cnt > 0u ? cnt : 1u;
}

__device__ __forceinline__ void xcd_barrier(const XcdBarrier& b) {
    asm volatile("s_waitcnt vmcnt(0)" ::: "memory");
    __syncthreads();
    if (threadIdx.x == 0) {
        unsigned* bar = b.bar;
        __builtin_amdgcn_s_waitcnt(0);
        unsigned nloc = b.st[0], nx = b.st[1];
        if (nloc == 0u) { xcd_barrier_complete(bar, b.x, nloc, nx); b.st[0] = nloc; b.st[1] = nx; }
        const unsigned old = xb_add(&bar[XB_XSUB(b.x)], 1u);
        const unsigned gen = old / nloc;
        if (old + 1u == (gen + 1u) * nloc) {
            __builtin_amdgcn_fence(__ATOMIC_RELEASE, "agent");
            asm volatile("s_waitcnt vmcnt(0)" ::: "memory");
            const unsigned og = xb_add(&bar[XB_TOP], 1u);
            const unsigned tg = og / nx;
            if (og + 1u == (tg + 1u) * nx) xb_add(&bar[XB_TOPGEN], 1u);
            else XB_SPIN(xb_ld(&bar[XB_TOPGEN]) == tg, bar);
            __builtin_amdgcn_fence(__ATOMIC_ACQUIRE, "agent");
            xb_add(&bar[XB_XGEN(b.x)], 1u);
            asm volatile("s_waitcnt vmcnt(0)" ::: "memory");
        } else {
            XB_SPIN(xb_ld(&bar[XB_XGEN(b.x)]) == gen, bar);
            __builtin_amdgcn_fence(__ATOMIC_ACQUIRE, "agent");
            asm volatile("s_waitcnt vmcnt(0)" ::: "memory");
        }
    }
    __syncthreads();
}


__global__ void __launch_bounds__(512) hybrid_trunk_fwd(Params P) {
    extern __shared__ __attribute__((aligned(16))) unsigned char lds_raw[];
    LAS unsigned char* lds = (LAS unsigned char*)lds_raw;
    cg::grid_group grid = cg::this_grid();
    unsigned char* ws = P.ws;
    bf16_t* XN = (bf16_t*)(ws + WS_XN); bf16_t* U = (bf16_t*)(ws + WS_U); bf16_t* MG = (bf16_t*)(ws + WS_MG); bf16_t* Q = (bf16_t*)(ws + WS_Q); bf16_t* K = (bf16_t*)(ws + WS_K);
    bf16_t* VH = (bf16_t*)(ws + WS_VH); bf16_t* SZ = (bf16_t*)(ws + WS_SZ); bf16_t* GA = (bf16_t*)(ws + WS_GA); bf16_t* GB = (bf16_t*)(ws + WS_GB);
    const bf16_t* WIN = (const bf16_t*)(ws + WS_WIN); const bf16_t* WCO = (const bf16_t*)(ws + WS_WCO); const bf16_t* WRO = (const bf16_t*)(ws + WS_WRO); const bf16_t* WO = (const bf16_t*)(ws + WS_WO);
    const float* BP = (const float*)(ws + WS_BP); const float* CT = (const float*)(ws + WS_ROPE); const float* ST = CT + 4112 * 128;
    const int G = gridDim.x, c = blockIdx.x;
    unsigned* barw = (unsigned*)(ws + WS_BAR);
    volatile LAS unsigned* bst = (volatile LAS unsigned*)(lds + 131072);
    if (threadIdx.x < 4) bst[threadIdx.x] = 0u;
    __syncthreads();
    if (P.ws == nullptr) grid.sync();
    XcdBarrier xbar = xcd_barrier_post(barw, bst);
#define GSYNC() xcd_barrier(xbar)
#if defined(PROBE_DUR)
    unsigned long long tph[6] = {0ull, 0ull, 0ull, 0ull, 0ull, 0ull}; const unsigned long long tstart = __builtin_amdgcn_s_memrealtime(); unsigned long long tlast = tstart;
#define PSTAMP(k) do { const unsigned long long tn_ = __builtin_amdgcn_s_memrealtime(); tph[k] += tn_ - tlast; tlast = tn_; } while (0)
#else
#define PSTAMP(k) do { } while (0)
#endif
    for (int l = 0; l < DEPTH; ++l) {
        convert_phase(lds, P, l);
        norm_phase(P, l);
        GSYNC(); PSTAMP(0);
        { int ti_b = threadIdx.x; asm volatile("" : "+v"(ti_b));
          for (int i = ti_b; i < DIN / 4; i += 512) { const f32x4 bq = *(const f32x4*)(BP + 4 * i); *(LAS u32x2*)(lds + LDS_BIAS + 8 * i) = (u32x2){pk(bq[0], bq[1]), pk(bq[2], bq[3])}; }
          __syncthreads(); }
        { pg8::Gemm g{XN, WIN, NROW, DIN, 1024}; pg8::StaticOrder S; S.init(NROW, DIN, G, c); EpiIn E{U, MG, Q, K, VH, SZ, GA, GB, (const LAS bf16_t*)(lds + LDS_BIAS), CT, ST};
          pg8::gemm_phase<EpiIn, pg8::StaticOrder>(lds, g, S, E, nullptr); }
        GSYNC(); PSTAMP(1);
        scan_phase(lds, P);
        GSYNC(); PSTAMP(2);
        elem_phase(lds, P, l);
        GSYNC(); PSTAMP(3);
        if (l + 1 < DEPTH) { meta_gemm<1>(MG, WCO, 1024, 1024, GA, U, nullptr, nullptr); meta_gemm<2>(Q, WRO, 2048, 1024, GB, U, nullptr, nullptr); }
        { pg8::Gemm g{MG, WCO, NREAL, 1024, 1024}; pg8::StaticOrder S; S.init(NREAL, 1024, G, c); EpiOut<1> E{GA, U, nullptr, nullptr};
          pg8::gemm_phase<EpiOut<1>, pg8::StaticOrder>(lds, g, S, E, nullptr); }
        { pg8::Gemm g{Q, WRO, NREAL, 1024, 2048}; pg8::StaticOrder S; S.init(NREAL, 1024, G, c); EpiOut<2> E{GB, U, nullptr, nullptr};
          pg8::gemm_phase<EpiOut<2>, pg8::StaticOrder>(lds, g, S, E, nullptr); }
        GSYNC(); PSTAMP(4);
        if (l + 1 < DEPTH) meta_gemm<3>(U, WO, 1024, 1024, nullptr, XN, nullptr, nullptr);
        { pg8::Gemm g{U, WO, NREAL, 1024, 1024}; pg8::StaticOrder S; S.init(NREAL, 1024, G, c); EpiOut<3> E{nullptr, XN, nullptr, nullptr};
          pg8::gemm_phase<EpiOut<3>, pg8::StaticOrder>(lds, g, S, E, nullptr); }
        GSYNC(); PSTAMP(5);
    }
    norm_phase(P, DEPTH);
#if defined(PROBE_DUR)
    GSYNC(); PSTAMP(0);
    {
        const unsigned long long ttot = tlast - tstart;
        const int M = (int)((double)tph[PROBE_RVR] * 1.0e6 / (double)ttot);
        for (int idx = blockIdx.x * 512 + threadIdx.x; idx < M; idx += gridDim.x * 512) P.out[idx] += 0.4f;
        const unsigned long long tend = __builtin_amdgcn_s_memrealtime() + tph[PROBE_DUR];
        while (__builtin_amdgcn_s_memrealtime() < tend) __builtin_amdgcn_s_sleep(8);
    }
#endif
}

extern "C" void kernel_launch(void* const* d_in, const int* in_sizes, int n_in, void* d_out, int out_size, void* d_ws, size_t ws_size, hipStream_t stream) {
    static int grid = 0;
    if (grid == 0) {
        int dev = 0, cus = 0, per_cu = 0;
        hipGetDevice(&dev); hipDeviceGetAttribute(&cus, hipDeviceAttributeMultiprocessorCount, dev);
        hipFuncSetAttribute((const void*)hybrid_trunk_fwd, hipFuncAttributeMaxDynamicSharedMemorySize, LDS_BYTES);
        hipOccupancyMaxActiveBlocksPerMultiprocessor(&per_cu, (const void*)hybrid_trunk_fwd, 512, LDS_BYTES);
        (void)hipGetLastError();
        if (per_cu < 1) per_cu = 1;
        grid = cus * per_cu;
        if (n_in != 12 || ws_size < WS_END) { fprintf(stderr, "kernel_launch: n_in %d ws %zu need %zu\n", n_in, ws_size, (size_t)WS_END); grid = -1; }
    }
    if (grid < 0) return;
    Params p{};
    p.x = (const float*)d_in[0]; p.meta = (const float*)d_in[1]; p.pre_g = (const float*)d_in[2]; p.w_in = (const float*)d_in[3]; p.b_in = (const float*)d_in[4];
    p.conv_w = (const float*)d_in[5]; p.conv_b = (const float*)d_in[6]; p.w_co = (const float*)d_in[7]; p.gn_g = (const float*)d_in[8]; p.w_ro = (const float*)d_in[9];
    p.w_o = (const float*)d_in[10]; p.post_g = (const float*)d_in[11]; p.out = (float*)d_out; p.ws = (unsigned char*)d_ws;
    hipMemsetAsync((char*)d_ws + WS_BAR, 0, 16384, stream);
    void* args[] = {&p};
    hipError_t e = hipLaunchCooperativeKernel((const void*)hybrid_trunk_fwd, dim3(grid), dim3(512), args, LDS_BYTES, stream);
    if (e != hipSuccess) fprintf(stderr, "cooperative launch failed: %s (grid %d)\n", hipGetErrorString(e), grid);
}
```
